# Optimizing an MI355X kernel written in HIP

```python
import jax, jax.numpy as jnp
from jax import lax
import numpy as np

D_MODEL = 1024
BATCH = 16
SEQ = 2048
DEPTH = 2

HEAD_DIM = 64
MOBA_HEADS = 8
MOBA_BLOCK = 256
MOBA_TOPK = 3
MOBA_Q_CHUNK = 16
DIL_PATTERNS = ((128, 1), (512, 4), (2048, 16))
DIL_HEADS_PER_GROUP = 4
N_DIL_GROUPS = 3
ROPE_THETA = 10000.0
RMS_EPS = 1e-6
D_FF_DENSE = 2816
N_EXPERTS = 8
TOP_K = 2
D_FF_EXPERT = 3584

WIDTH_A = MOBA_HEADS * HEAD_DIM
WIDTH_B = N_DIL_GROUPS * DIL_HEADS_PER_GROUP * HEAD_DIM
WIDTH_B_OUT = DIL_HEADS_PER_GROUP * HEAD_DIM
IN_PROJ_COLS = 3 * WIDTH_A + 3 * WIDTH_B + 2 * D_MODEL

kernel_name = 'hybrid_moba_dilated_gated_moe'


def rms_norm(x, g):
    xf = x.astype(jnp.float32)
    y = xf * lax.rsqrt(jnp.mean(xf * xf, axis=-1, keepdims=True) + RMS_EPS)
    return (y * g.astype(jnp.float32)).astype(x.dtype)


def rope(x, pos):
    half = x.shape[-1] // 2
    inv = ROPE_THETA ** (-jnp.arange(half, dtype=jnp.float32) / half)
    ang = pos.astype(jnp.float32)[:, None] * inv[None, :]
    cos = jnp.cos(ang)[None, :, None, :]
    sin = jnp.sin(ang)[None, :, None, :]
    x1 = x[..., :half].astype(jnp.float32)
    x2 = x[..., half:].astype(jnp.float32)
    return jnp.concatenate([x1 * cos - x2 * sin, x2 * cos + x1 * sin], axis=-1).astype(x.dtype)


def moba_attention(q, k, v):
    bsz, seq, n_heads, head_dim = q.shape
    n_blk = -(-seq // MOBA_BLOCK)
    seq_p = n_blk * MOBA_BLOCK
    pad = ((0, 0), (0, seq_p - seq), (0, 0), (0, 0))
    qh = jnp.pad(q, pad).transpose(0, 2, 1, 3)
    k_blk = jnp.pad(k, pad).transpose(0, 2, 1, 3).reshape(bsz, n_heads, n_blk, MOBA_BLOCK, head_dim)
    v_blk = jnp.pad(v, pad).transpose(0, 2, 1, 3).reshape(bsz, n_heads, n_blk, MOBA_BLOCK, head_dim)
    scale = head_dim ** -0.5
    q_blk_id = jnp.arange(seq_p) // MOBA_BLOCK
    n_sel = min(MOBA_TOPK, n_blk - 1)
    if n_sel > 0:
        k_mean = jnp.mean(k_blk.astype(jnp.float32), axis=3)
        gate = jnp.einsum('bhsd,bhnd->bhsn', qh.astype(jnp.float32), k_mean)
        fully_past = jnp.arange(n_blk)[None, :] < q_blk_id[:, None]
        gate = jnp.where(fully_past, gate, -jnp.inf)
        _, sel = lax.top_k(gate, n_sel)
        sel_ok = sel < q_blk_id[:, None]
    gather = jax.vmap(jax.vmap(lambda kb, ix: kb[ix]))
    local = jnp.arange(MOBA_BLOCK)

    def chunk(c):
        start = c * MOBA_Q_CHUNK
        blk = start // MOBA_BLOCK
        qc = lax.dynamic_slice_in_dim(qh, start, MOBA_Q_CHUNK, axis=2)
        k_own = lax.dynamic_index_in_dim(k_blk, blk, axis=2, keepdims=False)
        v_own = lax.dynamic_index_in_dim(v_blk, blk, axis=2, keepdims=False)
        q_pos = start + jnp.arange(MOBA_Q_CHUNK)
        k_pos = blk * MOBA_BLOCK + local
        s_own = jnp.einsum('bhqd,bhkd->bhqk', qc, k_own).astype(jnp.float32) * scale
        s_own = jnp.where(k_pos[None, :] <= q_pos[:, None], s_own, -jnp.inf)
        if n_sel == 0:
            p = jax.nn.softmax(s_own, axis=-1).astype(v.dtype)
            return jnp.einsum('bhqk,bhkd->bhqd', p, v_own)
        sel_c = lax.dynamic_slice_in_dim(sel, start, MOBA_Q_CHUNK, axis=2)
        ok_c = lax.dynamic_slice_in_dim(sel_ok, start, MOBA_Q_CHUNK, axis=2)
        k_sel = gather(k_blk, sel_c)
        v_sel = gather(v_blk, sel_c)
        s_sel = jnp.einsum('bhqd,bhqnkd->bhqnk', qc, k_sel).astype(jnp.float32) * scale
        s_sel = jnp.where(ok_c[..., None], s_sel, -jnp.inf)
        n_past = n_sel * MOBA_BLOCK
        s = jnp.concatenate([s_sel.reshape(bsz, n_heads, MOBA_Q_CHUNK, n_past), s_own], axis=-1)
        p = jax.nn.softmax(s, axis=-1).astype(v.dtype)
        p_sel = p[..., :n_past].reshape(bsz, n_heads, MOBA_Q_CHUNK, n_sel, MOBA_BLOCK)
        return (jnp.einsum('bhqnk,bhqnkd->bhqd', p_sel, v_sel)
                + jnp.einsum('bhqk,bhkd->bhqd', p[..., n_past:], v_own))

    out = lax.map(chunk, jnp.arange(seq_p // MOBA_Q_CHUNK))
    out = out.transpose(1, 0, 3, 2, 4).reshape(bsz, seq_p, n_heads, head_dim)
    return out[:, :seq]


def dilated_window_attention(q, k, v, dilation, steps):
    bsz, seq, n_heads, head_dim = q.shape
    sub = seq // dilation

    def to_residue(t):
        return t.reshape(bsz, sub, dilation, n_heads, head_dim).transpose(0, 2, 1, 3, 4).reshape(
            bsz * dilation, sub, n_heads, head_dim)

    def from_residue(t):
        tail = t.shape[2:]
        return t.reshape((bsz, dilation, sub) + tail).transpose((0, 2, 1) + tuple(range(3, 3 + len(tail)))).reshape(
            (bsz, seq) + tail)

    qr, kr, vr = to_residue(q), to_residue(k), to_residue(v)
    rows = bsz * dilation
    n_blk = -(-sub // steps)
    sub_p = n_blk * steps
    qb = jnp.pad(qr, ((0, 0), (0, sub_p - sub), (0, 0), (0, 0))).reshape(rows, n_blk, steps, n_heads, head_dim)
    kv_pad = ((0, 0), (steps, sub_p - sub), (0, 0), (0, 0))
    kp = jnp.pad(kr, kv_pad)
    vp = jnp.pad(vr, kv_pad)

    def band(t):
        return jnp.concatenate([t[:, :sub_p].reshape(rows, n_blk, steps, n_heads, head_dim),
                                t[:, steps:].reshape(rows, n_blk, steps, n_heads, head_dim)], axis=2)

    kb, vb = band(kp), band(vp)
    s = jnp.einsum('nbqhd,nbkhd->nbhqk', qb, kb).astype(jnp.float32) * (head_dim ** -0.5)
    qi = jnp.arange(steps)[:, None]
    kj = jnp.arange(2 * steps)[None, :]
    key_idx = jnp.arange(n_blk)[:, None, None] * steps - steps + kj
    mask = (kj >= qi) & (kj <= qi + steps) & (key_idx >= 0)
    s = jnp.where(mask[None, :, None], s, -jnp.inf)
    lse = jax.nn.logsumexp(s, axis=-1)
    p = jnp.exp(s - lse[..., None]).astype(v.dtype)
    o = jnp.einsum('nbhqk,nbkhd->nbqhd', p, vb).reshape(rows, sub_p, n_heads, head_dim)[:, :sub]
    lse = lse.transpose(0, 1, 3, 2).reshape(rows, sub_p, n_heads)[:, :sub]
    return from_residue(o), from_residue(lse)


def dilated_mixture(q, k, v):
    outs, lses = [], []
    for g, (window, dilation) in enumerate(DIL_PATTERNS):
        sl = slice(g * DIL_HEADS_PER_GROUP, (g + 1) * DIL_HEADS_PER_GROUP)
        o, l = dilated_window_attention(q[:, :, sl], k[:, :, sl], v[:, :, sl], dilation, window // dilation)
        outs.append(o)
        lses.append(l)
    w = jax.nn.softmax(jnp.stack(lses, axis=0), axis=0).astype(q.dtype)
    return jnp.sum(w[..., None] * jnp.stack(outs, axis=0), axis=0)


def mixer_block(h, w_in, w_proj_a, w_proj_b, w_out):
    bsz, seq, _ = h.shape
    proj = jnp.einsum('bsd,dc->bsc', h, w_in)
    sizes = [WIDTH_A] * 3 + [WIDTH_B] * 3 + [D_MODEL] * 2
    qa, ka, va, qb, kb, vb, ga, gb = jnp.split(proj, np.cumsum(sizes)[:-1].tolist(), axis=-1)
    pos = jnp.arange(seq)
    heads_a = (bsz, seq, MOBA_HEADS, HEAD_DIM)
    heads_b = (bsz, seq, N_DIL_GROUPS * DIL_HEADS_PER_GROUP, HEAD_DIM)
    oa = moba_attention(rope(qa.reshape(heads_a), pos), rope(ka.reshape(heads_a), pos), va.reshape(heads_a))
    ob = dilated_mixture(rope(qb.reshape(heads_b), pos), rope(kb.reshape(heads_b), pos), vb.reshape(heads_b))
    ya = jnp.einsum('bsc,cd->bsd', oa.reshape(bsz, seq, WIDTH_A), w_proj_a)
    yb = jnp.einsum('bsc,cd->bsd', ob.reshape(bsz, seq, WIDTH_B_OUT), w_proj_b)
    merged = jax.nn.sigmoid(ga) * ya + jax.nn.sigmoid(gb) * yb
    return jnp.einsum('bsd,de->bse', merged, w_out)


def swiglu(h, w_gate, w_up, w_down):
    a = jnp.einsum('bsd,df->bsf', h, w_gate)
    b = jnp.einsum('bsd,df->bsf', h, w_up)
    return jnp.einsum('bsf,fd->bsd', jax.nn.silu(a) * b, w_down)


def moe_swiglu(h, w_router, w_gate_e, w_up_e, w_down_e):
    logits = jnp.einsum('bsd,de->bse', h, w_router).astype(jnp.float32)
    top_val, top_idx = lax.top_k(logits, TOP_K)
    top_w = jax.nn.softmax(top_val, axis=-1)
    combine = jnp.sum(jax.nn.one_hot(top_idx, N_EXPERTS, dtype=jnp.float32) * top_w[..., None], axis=-2)
    combine = combine.astype(h.dtype)
    y = jnp.zeros_like(h)
    for e in range(N_EXPERTS):
        y = y + combine[..., e:e + 1] * swiglu(h, w_gate_e[e], w_up_e[e], w_down_e[e])
    return y


def setup_inputs(seed: int = 0) -> dict:
    key = jax.random.key(seed)
    keys = iter(jax.random.split(key, 32))

    def dense(shape, fan_in):
        return jax.random.normal(next(keys), shape, jnp.float32) * (fan_in ** -0.5)

    def gain():
        return 1.0 + 0.02 * jax.random.normal(next(keys), (D_MODEL,), jnp.float32)

    x = jax.random.normal(next(keys), (BATCH, SEQ, D_MODEL), jnp.float32)
    return {
        'x': x,
        'norm_mix_0': gain(),
        'w_in_0': dense((D_MODEL, IN_PROJ_COLS), D_MODEL),
        'w_proj_a_0': dense((WIDTH_A, D_MODEL), WIDTH_A),
        'w_proj_b_0': dense((WIDTH_B_OUT, D_MODEL), WIDTH_B_OUT),
        'w_out_0': dense((D_MODEL, D_MODEL), D_MODEL),
        'norm_ffn_0': gain(),
        'w_gate_0': dense((D_MODEL, D_FF_DENSE), D_MODEL),
        'w_up_0': dense((D_MODEL, D_FF_DENSE), D_MODEL),
        'w_down_0': dense((D_FF_DENSE, D_MODEL), D_FF_DENSE),
        'norm_mix_1': gain(),
        'w_in_1': dense((D_MODEL, IN_PROJ_COLS), D_MODEL),
        'w_proj_a_1': dense((WIDTH_A, D_MODEL), WIDTH_A),
        'w_proj_b_1': dense((WIDTH_B_OUT, D_MODEL), WIDTH_B_OUT),
        'w_out_1': dense((D_MODEL, D_MODEL), D_MODEL),
        'norm_ffn_1': gain(),
        'w_router_1': dense((D_MODEL, N_EXPERTS), D_MODEL),
        'w_gate_e_1': dense((N_EXPERTS, D_MODEL, D_FF_EXPERT), D_MODEL),
        'w_up_e_1': dense((N_EXPERTS, D_MODEL, D_FF_EXPERT), D_MODEL),
        'w_down_e_1': dense((N_EXPERTS, D_FF_EXPERT, D_MODEL), D_FF_EXPERT),
        'norm_final': gain(),
    }


def reference(x, norm_mix_0, w_in_0, w_proj_a_0, w_proj_b_0, w_out_0, norm_ffn_0, w_gate_0, w_up_0, w_down_0,
              norm_mix_1, w_in_1, w_proj_a_1, w_proj_b_1, w_out_1, norm_ffn_1, w_router_1, w_gate_e_1, w_up_e_1,
              w_down_e_1, norm_final):
    mixers = ((norm_mix_0, w_in_0, w_proj_a_0, w_proj_b_0, w_out_0),
              (norm_mix_1, w_in_1, w_proj_a_1, w_proj_b_1, w_out_1))
    ffns = ((norm_ffn_0, (w_gate_0, w_up_0, w_down_0)),
            (norm_ffn_1, (w_router_1, w_gate_e_1, w_up_e_1, w_down_e_1)))
    for layer in range(DEPTH):
        nm, wi, wa, wb, wo = mixers[layer]
        x = x + mixer_block(rms_norm(x, nm), wi, wa, wb, wo)
        nf, fp = ffns[layer]
        h = rms_norm(x, nf)
        if layer % 2 == 0:
            x = x + swiglu(h, *fp)
        else:
            x = x + moe_swiglu(h, *fp)
    return rms_norm(x, norm_final)
```

```cpp
#include <hip/hip_runtime.h>
#include <cstdio>
#include <cstdint>
#include <cmath>

#ifndef MK_MULTI
#define MK_MULTI 0
#endif

#define GAS __attribute__((address_space(1)))
#define LAS __attribute__((address_space(3)))
typedef unsigned short bf16;
typedef float f32x4 __attribute__((ext_vector_type(4)));
typedef float f32x2 __attribute__((ext_vector_type(2)));
typedef unsigned u32x4 __attribute__((ext_vector_type(4)));
typedef unsigned u32x2 __attribute__((ext_vector_type(2)));
typedef GAS unsigned gu32;
#define RLX_AGENT __ATOMIC_RELAXED, __HIP_MEMORY_SCOPE_AGENT

constexpr int BATCH = 16, SEQ = 2048, D = 1024, M = BATCH * SEQ;
constexpr int HD = 64, MOBA_H = 8, MOBA_BLK = 256, NBLK = SEQ / MOBA_BLK, MOBA_TOPK = 3;
constexpr int WA = 512, WB = 768, WBO = 256;
constexpr int NQKV = 3 * WA + 3 * WB;
constexpr int NIN = NQKV + 2 * D;
constexpr int C_QA = 0, C_KA = 512, C_VA = 1024, C_QB = 1536, C_KB = 2304, C_VB = 3072;
constexpr size_t HSLOT = (size_t)M * 64;
#define QKV_AT(base, col, row) ((base) + (size_t)((col) >> 6) * HSLOT + (size_t)(row) * 64 + ((col) & 63))
constexpr int FF0 = 2816, NEXP = 8, FFE = 3584;
constexpr float RMS_EPS = 1e-6f;
constexpr int NWAVES = 8, NTHREADS = 512;

constexpr size_t MiB = 1u << 20;
constexpr size_t WS_CTL = 0, CTL_ZERO_BYTES = 64 * 1024;
constexpr size_t WS_ROPE = 1 * MiB;
constexpr size_t WS_KMEAN = WS_ROPE + 512 * 1024;
constexpr size_t WS_COMB = 2 * MiB;
constexpr size_t WS_WSM = 4 * MiB;
constexpr size_t WSM_IN = 0, WSM_MRG = 2 * (size_t)NIN * D * 2, WSM_OUT = WSM_MRG + 2 * (size_t)D * 768 * 2, WSM_GU0 = WSM_OUT + 2 * (size_t)D * D * 2,
                 WSM_DN0 = WSM_GU0 + (size_t)2 * FF0 * D * 2, WSM_END = WSM_DN0 + (size_t)D * FF0 * 2;
static_assert(WSM_END <= 48 * MiB, "weight copies");
constexpr size_t WS_H = 52 * MiB;
constexpr size_t WS_BIG = 116 * MiB;
constexpr size_t WS_QKV = WS_BIG;
constexpr size_t WS_GATES = WS_QKV + (size_t)M * NQKV * 2;
constexpr size_t WS_ACT = WS_BIG;
constexpr size_t WS_END0 = WS_GATES + (size_t)M * 2 * D * 2;
constexpr int MOE_LROWS = M + NEXP * 256;
constexpr int MOE_CH_TILES = 64;
constexpr size_t WS_EXPW = WS_BIG;
constexpr size_t EXPW_DN = (size_t)NEXP * 2 * FFE * D * 2;
constexpr size_t WS_HS = WS_EXPW + (size_t)NEXP * 3 * FFE * D * 2;
constexpr size_t WS_ACT1 = WS_HS + (size_t)2 * MOE_LROWS * D * 2;
constexpr size_t WS_END1 = WS_ACT1 + (size_t)MOE_CH_TILES * 256 * FFE * 2;
constexpr size_t WS_END = WS_END0 > WS_END1 ? WS_END0 : WS_END1;
constexpr size_t WS_LSE = 2 * MiB;
constexpr size_t WS_TOK = 2 * MiB;
constexpr int CW_CNT = 8192, CW_FILL = 8192 + 64;
constexpr int CW_BAR = 4096;
constexpr int CW_CMB = 15488;
constexpr int CW_PCNT = 9216;
constexpr size_t WS_XCH = 128 * 1024;

__device__ __forceinline__ float bf2f(unsigned b) { return __uint_as_float(b << 16); }
__device__ __forceinline__ unsigned f2bf(float f) { unsigned u = __float_as_uint(f); return (u + 0x7fffu + ((u >> 16) & 1u)) >> 16; }
__device__ __forceinline__ unsigned pk2(float lo, float hi) { return f2bf(lo) | (f2bf(hi) << 16); }
template <int O> __device__ __forceinline__ float xor_lane(float v) { return __int_as_float(__builtin_amdgcn_ds_swizzle(__float_as_int(v), (O << 10) | 0x1f)); }
__device__ __forceinline__ float wave_sum(float v) {
    v += xor_lane<1>(v); v += xor_lane<2>(v); v += xor_lane<4>(v); v += xor_lane<8>(v); v += xor_lane<16>(v);
    { auto rr = __builtin_amdgcn_permlane32_swap(__float_as_uint(v), __float_as_uint(v), false, false); v = __uint_as_float(rr[0]) + __uint_as_float(rr[1]); }
    return v;
}
__device__ __forceinline__ float wave_max(float v) {
    v = fmaxf(v, xor_lane<1>(v)); v = fmaxf(v, xor_lane<2>(v)); v = fmaxf(v, xor_lane<4>(v)); v = fmaxf(v, xor_lane<8>(v)); v = fmaxf(v, xor_lane<16>(v));
    { auto rr = __builtin_amdgcn_permlane32_swap(__float_as_uint(v), __float_as_uint(v), false, false); v = fmaxf(__uint_as_float(rr[0]), __uint_as_float(rr[1])); }
    return v;
}

#define XB_TMO      128
#define XB_XCNT(j)  (256  + 64 * (j))
#define XB_XSUB(j)  (1280 + 64 * (j))
#define XB_XGEN(j)  (2304 + 64 * (j))
#define XB_TOP      3328
#define XB_TOPGEN   3392
#define XCD_BAR_WORDS 3456
#define XB_SPIN_CAP (1u << 22)

__device__ __forceinline__ unsigned xb_ld(unsigned* p)              { return __hip_atomic_load(p, __ATOMIC_RELAXED, __HIP_MEMORY_SCOPE_AGENT); }
__device__ __forceinline__ unsigned xb_add(unsigned* p, unsigned v) { return __hip_atomic_fetch_add(p, v, __ATOMIC_RELAXED, __HIP_MEMORY_SCOPE_AGENT); }
__device__ __forceinline__ unsigned xb_xcc_id() { return (unsigned)__builtin_amdgcn_s_getreg((3 << 11) | 20) & 0xFu; }
#define XB_SPIN(cond, bar) do { unsigned _sp = 0; while (cond) { __builtin_amdgcn_s_sleep(1); \
    if ((++_sp & 255u) == 0u) { if (xb_ld(&(bar)[XB_TMO])) break; if (_sp > XB_SPIN_CAP) { atomicAdd(&(bar)[XB_TMO], 1u); break; } } } } while (0)

struct XcdBarrier { unsigned* bar; unsigned x; volatile LAS unsigned* st; };

__device__ __forceinline__ XcdBarrier xcd_barrier_post(unsigned* bar, volatile LAS unsigned* st) {
    XcdBarrier b; b.bar = bar; b.x = xb_xcc_id(); b.st = st;
    if (threadIdx.x == 0) (void)xb_add(&bar[XB_XCNT(b.x)], 1u);
    return b;
}
__device__ __forceinline__ void xcd_barrier_complete(unsigned* bar, unsigned x, unsigned& nloc, unsigned& nx) {
    const unsigned G = gridDim.x * gridDim.y * gridDim.z;
    unsigned sum, cnt, mine, sp = 0u;
    for (;;) {
        sum = 0u; cnt = 0u; mine = 0u;
#pragma unroll
        for (unsigned j = 0; j < 16; ++j) { const unsigned c = xb_ld(&bar[XB_XCNT(j)]); sum += c; cnt += (c > 0u) ? 1u : 0u; mine = (j == x) ? c : mine; }
        if (sum == G) break;
        __builtin_amdgcn_s_sleep(1);
        if ((++sp & 255u) == 0u) { if (xb_ld(&bar[XB_TMO])) break; if (sp > XB_SPIN_CAP) { atomicAdd(&bar[XB_TMO], 1u); break; } }
    }
    nloc = mine > 0u ? mine : 1u; nx = cnt > 0u ? cnt : 1u;
}
__device__ __forceinline__ void xcd_barrier(const XcdBarrier& b) {
    asm volatile("s_waitcnt vmcnt(0)" ::: "memory");
    __syncthreads();
    if (threadIdx.x == 0) {
        unsigned* bar = b.bar;
        __builtin_amdgcn_s_waitcnt(0);
        unsigned nloc = b.st[0], nx = b.st[1];
        if (nloc == 0u) { xcd_barrier_complete(bar, b.x, nloc, nx); b.st[0] = nloc; b.st[1] = nx; }
        const unsigned old = xb_add(&bar[XB_XSUB(b.x)], 1u);
        const unsigned gen = old / nloc;
        if (old + 1u == (gen + 1u) * nloc) {
            __builtin_amdgcn_fence(__ATOMIC_RELEASE, "agent");
            asm volatile("s_waitcnt vmcnt(0)" ::: "memory");
            const unsigned og = xb_add(&bar[XB_TOP], 1u);
            const unsigned tg = og / nx;
            if (og + 1u == (tg + 1u) * nx) xb_add(&bar[XB_TOPGEN], 1u);
            else XB_SPIN(xb_ld(&bar[XB_TOPGEN]) == tg, bar);
            __builtin_amdgcn_fence(__ATOMIC_ACQUIRE, "agent");
            xb_add(&bar[XB_XGEN(b.x)], 1u);
            asm volatile("s_waitcnt vmcnt(0)" ::: "memory");
        } else {
            XB_SPIN(xb_ld(&bar[XB_XGEN(b.x)]) == gen, bar);
            __builtin_amdgcn_fence(__ATOMIC_ACQUIRE, "agent");
            asm volatile("s_waitcnt vmcnt(0)" ::: "memory");
        }
    }
    __syncthreads();
}

constexpr int RING_BYTES = 131072, LDS_BYTES = 147456, MISC_OFF = LDS_BYTES - 256;

__device__ __forceinline__ void st_bf16x4(bf16* p, f32x4 v) { u32x2 w; w.x = pk2(v[0], v[1]); w.y = pk2(v[2], v[3]); *(u32x2*)p = w; }

namespace pg8 {
typedef short bf16x8 __attribute__((ext_vector_type(8)));
constexpr int BM = 256, BK = 64, HALF = 128, HTB = HALF * BK * 2, STAGE_BYTES = 8 * HTB, NXCD = 8, WGM = 4;
__host__ __device__ __forceinline__ int lds_byte(int r, int c) { const int st = (r >> 4) * 2 + (c >> 5), rr = r & 15, cc = c & 31, ob = rr * 64 + cc * 2; return st * 1024 + (ob ^ (((ob >> 9) & 1) << 5)); }
__host__ __device__ __forceinline__ void stage_rc(int b, int& R, int& C) { const int st = b / 1024, sb = b % 1024, swz = sb ^ (((sb >> 9) & 1) << 5); R = (st >> 1) * 16 + swz / 64; C = (st & 1) * 32 + (swz % 64) / 2; }
__host__ __device__ __forceinline__ int perm32(int rho) { const int n = rho >> 4, i = rho & 15; return 8 * (i >> 2) + 4 * n + (i & 3); }
struct Unit { int pm, pn, sub, aux; };
struct TileOrder {
    int nM, nN, nwg, G, c, nskip = 0, iskip = 0;
    __device__ __forceinline__ void init(int nM_, int nN_, int G_, int c_) { nM = nM_; nN = nN_; nwg = nM * nN; G = G_; c = c_; nskip = 0; iskip = 0; }
    __device__ __forceinline__ bool tile(int i, int& pm, int& pn) const {
        const long L = c < nskip ? (long)iskip * (G - nskip) + (long)i * G + c
                                 : (i < iskip ? (long)i * (G - nskip) + (c - nskip) : (long)iskip * (G - nskip) + (long)(i - iskip) * G + c);
        if (L >= nwg) return false;
        int wgid = (int)L; { const int q = nwg / NXCD, r = nwg % NXCD, xcd = wgid % NXCD, off = wgid / NXCD; wgid = (xcd < r ? xcd * (q + 1) : r * (q + 1) + (xcd - r) * q) + off; }
        const int nig = WGM * nN, gid = wgid / nig, fm = gid * WGM, gsz = (nM - fm) < WGM ? (nM - fm) : WGM;
        pm = fm + ((wgid % nig) % gsz); pn = (wgid % nig) / gsz; return true;
    }
};
constexpr size_t KT_BYTES = (size_t)BM * BK * 2;
struct SchedPlain {
    TileOrder o; const char* A; const char* B; int lda, ldb, ntk; size_t kA = BK * 2, kB = BK * 2, atile = 0, btile = 0;
    __device__ __forceinline__ void rowmajor() { kA = kB = BK * 2; atile = (size_t)BM * lda * 2; btile = (size_t)BM * ldb * 2; }
    __device__ __forceinline__ void tiled() { lda = ldb = BK; kA = kB = KT_BYTES; atile = btile = (size_t)ntk * KT_BYTES; }
    __device__ __forceinline__ bool next(int i, Unit& u) const { u.sub = 0; u.aux = 0; return o.tile(i, u.pm, u.pn); }
    __device__ __forceinline__ const char* aptr(const Unit& u) const { return A + (size_t)u.pm * atile; }
    __device__ __forceinline__ const char* bptr(const Unit& u) const { return B + (size_t)u.pn * btile; }
    __device__ __forceinline__ int nt(const Unit&) const { return ntk; }
};
struct SchedMerge {
    static constexpr size_t kA = HSLOT * 2, kB = BK * 2;
    TileOrder o; const char* A1; const char* A2; const char* B; int lda, ldb;
    __device__ __forceinline__ bool next(int i, Unit& u) const { u.sub = i & 1; u.aux = 0; return o.tile(i >> 1, u.pm, u.pn); }
    __device__ __forceinline__ const char* aptr(const Unit& u) const { return (u.sub ? A2 : A1) + (size_t)u.pm * BM * lda * 2; }
    __device__ __forceinline__ const char* bptr(const Unit& u) const { return B + (size_t)u.pn * BM * ldb * 2 + (u.sub ? WA * 2 : 0); }
    __device__ __forceinline__ int nt(const Unit& u) const { return u.sub ? WBO / BK : WA / BK; }
};

typedef __bf16 bf16x2_t __attribute__((ext_vector_type(2)));
__device__ __forceinline__ unsigned cvt_pk_bf16(float lo, float hi) { const f32x2 v = {lo, hi}; const bf16x2_t b = __builtin_convertvector(v, bf16x2_t); return __builtin_bit_cast(unsigned, b); }
__device__ __forceinline__ u32x4 pack8(f32x4 a, f32x4 b) { u32x4 w; w.x = cvt_pk_bf16(a[0], a[1]); w.y = cvt_pk_bf16(a[2], a[3]); w.z = cvt_pk_bf16(b[0], b[1]); w.w = cvt_pk_bf16(b[2], b[3]); return w; }
__device__ __forceinline__ void unpack8(u32x4 w, f32x4& a, f32x4& b) {
    a = (f32x4){__uint_as_float(w.x << 16), __uint_as_float(w.x & 0xffff0000u), __uint_as_float(w.y << 16), __uint_as_float(w.y & 0xffff0000u)};
    b = (f32x4){__uint_as_float(w.z << 16), __uint_as_float(w.z & 0xffff0000u), __uint_as_float(w.w << 16), __uint_as_float(w.w & 0xffff0000u)}; }
__device__ __forceinline__ f32x4 isig4(f32x4 v) { f32x4 o;
#pragma unroll
    for (int i = 0; i < 4; ++i) o[i] = fminf(1.f + __builtin_amdgcn_exp2f(-v[i]), 1e18f); return o; }
__device__ __forceinline__ f32x4 sig4(f32x4 v) { f32x4 o;
#pragma unroll
    for (int i = 0; i < 4; ++i) o[i] = __builtin_amdgcn_rcpf(1.f + __builtin_amdgcn_exp2f(-v[i])); return o; }

struct EpiInProj {
    static constexpr bool PERM = true;
    bf16* QKV; bf16* GATES; float* KM;
    __device__ __forceinline__ bool keep(const Unit&) const { return false; }
    __device__ __forceinline__ void operator()(f32x4 (&acc)[2][2][4][2], const Unit& u, int wr, int wc, int fr, int fq) const {
        const int row0 = u.pm * BM + wr * 64 + fr, pn = u.pn;
        if (pn < 15) {
            const bool rope = !(pn == 4 || pn == 5 || pn >= 12), km = (pn == 2 || pn == 3);
            const int colL = pn * BM + 64 * wc + 8 * fq;
            float fi[8];
#pragma unroll
            for (int j = 0; j < 8; ++j) fi[j] = __builtin_amdgcn_exp2f(-(float)(8 * fq + j) * (13.287712379549449f / 32.0f)) * 0.15915494309189535f;
            f32x4 cs[4] = {(f32x4){0.f, 0.f, 0.f, 0.f}, (f32x4){0.f, 0.f, 0.f, 0.f}, (f32x4){0.f, 0.f, 0.f, 0.f}, (f32x4){0.f, 0.f, 0.f, 0.f}};
#pragma unroll
            for (int ai = 0; ai < 2; ++ai)
#pragma unroll
                for (int m = 0; m < 4; ++m) {
                    const int row = row0 + ai * HALF + m * 16;
                    f32x4 a0 = acc[ai][0][m][0], a1 = acc[ai][0][m][1], b0 = acc[ai][1][m][0], b1 = acc[ai][1][m][1];
                    if (rope) { const float pos = (float)(row & (SEQ - 1)); f32x4 c0, c1, s0, s1;
#pragma unroll
                        for (int j = 0; j < 4; ++j) { const float r0 = __builtin_amdgcn_fractf(pos * fi[j]), r1 = __builtin_amdgcn_fractf(pos * fi[4 + j]);
                            c0[j] = __builtin_amdgcn_cosf(r0); s0[j] = __builtin_amdgcn_sinf(r0); c1[j] = __builtin_amdgcn_cosf(r1); s1[j] = __builtin_amdgcn_sinf(r1); }
                        const f32x4 y0 = a0 * c0 - b0 * s0, y1 = a1 * c1 - b1 * s1, z0 = b0 * c0 + a0 * s0, z1 = b1 * c1 + a1 * s1;
                        a0 = y0; a1 = y1; b0 = z0; b1 = z1; }
                    if (pn < 2 || (pn >= 6 && pn < 9)) { const float c2 = 0.125f * 1.4426950408889634f; a0 *= c2; a1 *= c2; b0 *= c2; b1 *= c2; }
                    if (km) { cs[0] += a0; cs[1] += a1; cs[2] += b0; cs[3] += b1; }
                    bf16* p = QKV_AT(QKV, colL, row);
                    *(u32x4*)p = pack8(a0, a1); *(u32x4*)(p + 32) = pack8(b0, b1);
                }
            if (km) {
#pragma unroll
                for (int q = 0; q < 4; ++q)
#pragma unroll
                    for (int j = 0; j < 4; ++j) { float v = cs[q][j]; v += xor_lane<1>(v); v += xor_lane<2>(v); v += xor_lane<4>(v); v += xor_lane<8>(v); cs[q][j] = v; }
                if (fr == 0) { float* kp = KM + (size_t)u.pm * WA + (pn - 2) * BM + 64 * wc + 8 * fq;
#pragma unroll
                    for (int q = 0; q < 4; ++q)
#pragma unroll
                        for (int j = 0; j < 4; ++j) atomicAdd(kp + (q >> 1) * 32 + (q & 1) * 4 + j, cs[q][j] * (1.f / 256.f)); }
            }
        } else {
            const int col = (pn - 15) * BM + 32 * wc + 8 * fq;
#pragma unroll
            for (int ai = 0; ai < 2; ++ai)
#pragma unroll
                for (int m = 0; m < 4; ++m) { bf16* p = GATES + (size_t)(row0 + ai * HALF + m * 16) * (2 * D) + col;
#pragma unroll
                    for (int bj = 0; bj < 2; ++bj) *(u32x4*)(p + bj * HALF) = pack8(isig4(acc[ai][bj][m][0]), isig4(acc[ai][bj][m][1])); }
        }
    }
};
struct EpiSwiglu2 {
    static constexpr bool PERM = true;
    bf16* O; int ldo;
    __device__ __forceinline__ bool keep(const Unit&) const { return false; }
    __device__ __forceinline__ void operator()(f32x4 (&acc)[2][2][4][2], const Unit& u, int wr, int wc, int fr, int fq) const {
        const int r0 = wr * 64 + fr, col = u.pn * HALF + 32 * wc + 8 * fq;
        bf16* base = O + ((size_t)u.pm * (ldo >> 6) + (col >> 6)) * (BM * BK) + (col & 63);
#pragma unroll
        for (int ai = 0; ai < 2; ++ai)
#pragma unroll
            for (int m = 0; m < 4; ++m) { const f32x4 g0 = acc[ai][0][m][0], g1 = acc[ai][0][m][1];
                *(u32x4*)(base + (r0 + ai * HALF + m * 16) * BK) = pack8(g0 * sig4(g0) * acc[ai][1][m][0], g1 * sig4(g1) * acc[ai][1][m][1]); }
    }
};
struct EpiRes2 {
    static constexpr bool PERM = false;
    const float* xin; float* xout;
    __device__ __forceinline__ bool keep(const Unit&) const { return false; }
    __device__ __forceinline__ void operator()(f32x4 (&acc)[2][2][4][2], const Unit& u, int wr, int wc, int fr, int fq) const {
        const int row0 = u.pm * BM + wr * 64 + fr, col0 = u.pn * BM + wc * 32 + 4 * fq;
#pragma unroll
        for (int ai = 0; ai < 2; ++ai) { f32x4 b[4][2][2];
#pragma unroll
            for (int m = 0; m < 4; ++m) { const size_t off = (size_t)(row0 + ai * HALF + m * 16) * D + col0;
#pragma unroll
                for (int bj = 0; bj < 2; ++bj)
#pragma unroll
                    for (int n = 0; n < 2; ++n) b[m][bj][n] = *(const f32x4*)(xin + off + bj * HALF + n * 16); }
#pragma unroll
            for (int m = 0; m < 4; ++m) { const size_t off = (size_t)(row0 + ai * HALF + m * 16) * D + col0;
#pragma unroll
                for (int bj = 0; bj < 2; ++bj)
#pragma unroll
                    for (int n = 0; n < 2; ++n) *(f32x4*)(xout + off + bj * HALF + n * 16) = b[m][bj][n] + acc[ai][bj][m][n]; } }
    }
};
struct EpiResNorm {
    static constexpr bool PERM = true;
    const float* xin; float* xout; const float* g; bf16* H; float* xch; gu32* cnt; LAS unsigned char* tab;
    __device__ __forceinline__ bool keep(const Unit&) const { return false; }
    __device__ __forceinline__ void operator()(f32x4 (&acc)[2][2][4][2], const Unit& u, int wr, int wc, int fr, int fq) const {
        const int wid = wr * 4 + wc, lane = fr + 16 * fq;
        const int row0 = u.pm * BM + wr * 64 + fr, col0 = u.pn * BM + 32 * wc + 8 * fq;
        LAS float* P = (LAS float*)tab; LAS float* S = P + 1024; LAS unsigned* flag = (LAS unsigned*)(S + 256);
#pragma unroll
        for (int ai = 0; ai < 2; ++ai) { f32x4 b[4][2][2];
#pragma unroll
            for (int m = 0; m < 4; ++m) { const size_t off = (size_t)(row0 + ai * HALF + m * 16) * D + col0;
#pragma unroll
                for (int bj = 0; bj < 2; ++bj)
#pragma unroll
                    for (int n = 0; n < 2; ++n) b[m][bj][n] = *(const f32x4*)(xin + off + bj * HALF + n * 4); }
#pragma unroll
            for (int m = 0; m < 4; ++m) { const size_t off = (size_t)(row0 + ai * HALF + m * 16) * D + col0; float q = 0.f;
#pragma unroll
                for (int bj = 0; bj < 2; ++bj)
#pragma unroll
                    for (int n = 0; n < 2; ++n) { const f32x4 v = b[m][bj][n] + acc[ai][bj][m][n]; acc[ai][bj][m][n] = v; *(f32x4*)(xout + off + bj * HALF + n * 4) = v; q += (v[0] * v[0] + v[1] * v[1]) + (v[2] * v[2] + v[3] * v[3]); }
                q += xor_lane<16>(q); { auto rr = __builtin_amdgcn_permlane32_swap(__float_as_uint(q), __float_as_uint(q), false, false); q = __uint_as_float(rr[0]) + __uint_as_float(rr[1]); }
                if (fq == 0) P[(ai * HALF + wr * 64 + m * 16 + fr) * 4 + wc] = q; } }
        asm volatile("s_waitcnt lgkmcnt(0)\n\ts_barrier" ::: "memory");
        const int row = wid * 32 + (lane & 31);
        if (lane < 32) { const float t = (P[row * 4 + 0] + P[row * 4 + 1]) + (P[row * 4 + 2] + P[row * 4 + 3]);
            __hip_atomic_store(xch + ((size_t)(u.pm * BM + row)) * 4 + u.pn, t, __ATOMIC_RELAXED, __HIP_MEMORY_SCOPE_AGENT); }
        asm volatile("s_waitcnt vmcnt(0)" ::: "memory");
        if (lane == 0) __hip_atomic_fetch_add(cnt + 16 * u.pm, 1u, RLX_AGENT);
        if (wid == 0) { unsigned sp = 0, dead = 0;
            while ((unsigned)__builtin_amdgcn_readfirstlane((int)__hip_atomic_load(cnt + 16 * u.pm, RLX_AGENT)) < 32u) { __builtin_amdgcn_s_sleep(2); if (++sp > (1u << 22)) { dead = 1; break; } }
            __builtin_amdgcn_fence(__ATOMIC_ACQUIRE, "agent");
            if (lane == 0) flag[0] = dead; }
        asm volatile("s_waitcnt vmcnt(0) lgkmcnt(0)\n\ts_barrier" ::: "memory");
        if (lane < 32) { const float* sl = xch + ((size_t)(u.pm * BM + row)) * 4;
            const float t0 = __hip_atomic_load(sl + 0, RLX_AGENT), t1 = __hip_atomic_load(sl + 1, RLX_AGENT), t2 = __hip_atomic_load(sl + 2, RLX_AGENT), t3 = __hip_atomic_load(sl + 3, RLX_AGENT);
            float rs = 1.0f / sqrtf(((t0 + t1) + (t2 + t3)) * (1.f / D) + RMS_EPS); if (flag[0]) rs = __builtin_nanf("");
            S[row] = rs; }
        asm volatile("s_waitcnt vmcnt(0) lgkmcnt(0)\n\ts_barrier" ::: "memory");
        f32x4 gv[2][2];
#pragma unroll
        for (int bj = 0; bj < 2; ++bj)
#pragma unroll
            for (int n = 0; n < 2; ++n) gv[bj][n] = *(const f32x4*)(g + col0 + bj * HALF + n * 4);
#pragma unroll
        for (int ai = 0; ai < 2; ++ai)
#pragma unroll
            for (int m = 0; m < 4; ++m) { const int r = ai * HALF + wr * 64 + m * 16 + fr; const float rs = S[r]; bf16* hp = H + (size_t)(u.pm * BM + r) * D + col0;
#pragma unroll
                for (int bj = 0; bj < 2; ++bj) *(u32x4*)(hp + bj * HALF) = pack8(acc[ai][bj][m][0] * rs * gv[bj][0], acc[ai][bj][m][1] * rs * gv[bj][1]); }
        asm volatile("s_waitcnt lgkmcnt(0)\n\ts_barrier" ::: "memory");
    }
};
struct EpiMerge2 {
    static constexpr bool PERM = true;
    const bf16* G; bf16* O;
    __device__ __forceinline__ bool keep(const Unit& u) const { return u.sub == 0; }
    __device__ __forceinline__ void operator()(f32x4 (&acc)[2][2][4][2], const Unit& u, int wr, int wc, int fr, int fq) const {
        const int row0 = u.pm * BM + wr * 64 + fr, col = u.pn * BM + 32 * wc + 8 * fq;
#pragma unroll
        for (int ai = 0; ai < 2; ++ai) { u32x4 gbv[4][2], gav[4][2];
#pragma unroll
            for (int m = 0; m < 4; ++m) { const size_t r = (size_t)(row0 + ai * HALF + m * 16);
#pragma unroll
                for (int bj = 0; bj < 2; ++bj) { gbv[m][bj] = *(const u32x4*)(G + r * (2 * D) + D + col + bj * HALF); if (u.sub == 0) gav[m][bj] = *(const u32x4*)(G + r * (2 * D) + col + bj * HALF); } }
#pragma unroll
            for (int m = 0; m < 4; ++m) { const size_t r = (size_t)(row0 + ai * HALF + m * 16);
#pragma unroll
                for (int bj = 0; bj < 2; ++bj) { f32x4 gb0, gb1; unpack8(gbv[m][bj], gb0, gb1);
                    if (u.sub == 0) { f32x4 ga0, ga1; unpack8(gav[m][bj], ga0, ga1);
#pragma unroll
                        for (int j = 0; j < 4; ++j) { acc[ai][bj][m][0][j] *= gb0[j] * __builtin_amdgcn_rcpf(ga0[j]); acc[ai][bj][m][1][j] *= gb1[j] * __builtin_amdgcn_rcpf(ga1[j]); } }
                    else { f32x4 r0, r1;
#pragma unroll
                        for (int j = 0; j < 4; ++j) { r0[j] = __builtin_amdgcn_rcpf(gb0[j]); r1[j] = __builtin_amdgcn_rcpf(gb1[j]); }
                        *(u32x4*)(O + r * D + col + bj * HALF) = pack8(acc[ai][bj][m][0] * r0, acc[ai][bj][m][1] * r1); } } } }
    }
};

struct SchedMoe {
    TileOrder o; const char* A; const char* B; int lda, ldb, ntk, rt0; size_t estride; bool a_chunk_local; int ts1, ts2, ts3, ts4, ts5, ts6, ts7; size_t kA = BK * 2, kB = BK * 2, atile = 0, btile = 0;
    __device__ __forceinline__ void rowmajor() { kA = kB = BK * 2; atile = (size_t)BM * lda * 2; btile = (size_t)BM * ldb * 2; }
    __device__ __forceinline__ void tiled() { lda = ldb = BK; kA = kB = KT_BYTES; atile = btile = (size_t)ntk * KT_BYTES; }
    __device__ __forceinline__ bool next(int i, Unit& u) const { const bool ok = o.tile(i, u.pm, u.pn); if (!ok) return false;
        const int rt = rt0 + u.pm; u.aux = rt; u.sub = (rt >= ts1) + (rt >= ts2) + (rt >= ts3) + (rt >= ts4) + (rt >= ts5) + (rt >= ts6) + (rt >= ts7); return true; }
    __device__ __forceinline__ const char* aptr(const Unit& u) const { return A + (size_t)(a_chunk_local ? u.pm : u.aux) * atile; }
    __device__ __forceinline__ const char* bptr(const Unit& u) const { return B + (size_t)u.sub * estride + (size_t)u.pn * btile; }
    __device__ __forceinline__ int nt(const Unit&) const { return ntk; }
};
struct EpiMoeDown2 {
    static constexpr bool PERM = false;
    float* x; const int* tokrow; const float* wrow;
    __device__ __forceinline__ bool keep(const Unit&) const { return false; }
    __device__ __forceinline__ void operator()(f32x4 (&acc)[2][2][4][2], const Unit& u, int wr, int wc, int fr, int fq) const {
        const int row0 = u.aux * BM + wr * 64 + fr, col0 = u.pn * BM + wc * 32 + 4 * fq;
        int tok[2][4]; float w[2][4];
#pragma unroll
        for (int ai = 0; ai < 2; ++ai)
#pragma unroll
            for (int m = 0; m < 4; ++m) { const int srow = row0 + ai * HALF + m * 16; tok[ai][m] = tokrow[srow]; w[ai][m] = wrow[srow]; }
#pragma unroll
        for (int ai = 0; ai < 2; ++ai) { f32x4 b[4][2][2];
#pragma unroll
            for (int m = 0; m < 4; ++m) { const float* xp = x + (size_t)(tok[ai][m] < 0 ? 0 : tok[ai][m]) * D + col0;
#pragma unroll
                for (int bj = 0; bj < 2; ++bj)
#pragma unroll
                    for (int n = 0; n < 2; ++n) b[m][bj][n] = *(const f32x4*)(xp + bj * HALF + n * 16); }
#pragma unroll
            for (int m = 0; m < 4; ++m) if (tok[ai][m] >= 0) { float* xp = x + (size_t)tok[ai][m] * D + col0;
#pragma unroll
                for (int bj = 0; bj < 2; ++bj)
#pragma unroll
                    for (int n = 0; n < 2; ++n) *(f32x4*)(xp + bj * HALF + n * 16) = b[m][bj][n] + acc[ai][bj][m][n] * w[ai][m]; } }
    }
};

struct EpiMoeDownA {
    static constexpr bool PERM = true;
    bf16* PA; const float* wrow;
    __device__ __forceinline__ bool keep(const Unit&) const { return false; }
    __device__ __forceinline__ void operator()(f32x4 (&acc)[2][2][4][2], const Unit& u, int wr, int wc, int fr, int fq) const {
        const int row0 = u.aux * BM + wr * 64 + fr, col0 = u.pn * BM + 32 * wc + 8 * fq;
#pragma unroll
        for (int ai = 0; ai < 2; ++ai)
#pragma unroll
            for (int m = 0; m < 4; ++m) { const int srow = row0 + ai * HALF + m * 16; const float w = wrow[srow]; bf16* p = PA + (size_t)srow * D + col0;
#pragma unroll
                for (int bj = 0; bj < 2; ++bj) *(u32x4*)(p + bj * HALF) = pack8(acc[ai][bj][m][0] * w, acc[ai][bj][m][1] * w); }
    }
};
struct EpiMoeDownNorm {
    static constexpr bool PERM = false;
    float* x; const int* tokrow; const float* wrow; const float* g; float* xch; gu32* cnt; LAS unsigned char* tab; const bf16* PA; const int* tokposA;
    __device__ __forceinline__ bool keep(const Unit&) const { return false; }
    __device__ __forceinline__ void operator()(f32x4 (&acc)[2][2][4][2], const Unit& u, int wr, int wc, int fr, int fq) const {
        const int wid = wr * 4 + wc, lane = fr + 16 * fq;
        const int row0 = u.aux * BM + wr * 64 + fr, col0 = u.pn * BM + wc * 32 + 4 * fq;
        LAS float* P = (LAS float*)tab; LAS float* S = P + 1024; LAS unsigned* flag = (LAS unsigned*)(S + 256);
        int tok[2][4]; float w[2][4]; int pa[2][4];
#pragma unroll
        for (int ai = 0; ai < 2; ++ai)
#pragma unroll
            for (int m = 0; m < 4; ++m) { const int srow = row0 + ai * HALF + m * 16; tok[ai][m] = tokrow[srow]; w[ai][m] = wrow[srow]; }
#pragma unroll
        for (int ai = 0; ai < 2; ++ai)
#pragma unroll
            for (int m = 0; m < 4; ++m) pa[ai][m] = tokposA[tok[ai][m] < 0 ? 0 : tok[ai][m]];
#pragma unroll
        for (int am = 0; am < 4; ++am) { const int ai = am >> 1; f32x4 b[4][2][2]; u32x2 pv[4][2][2];
#pragma unroll
            for (int m = 2 * (am & 1); m < 2 * (am & 1) + 2; ++m) { const float* xp = x + (size_t)(tok[ai][m] < 0 ? 0 : tok[ai][m]) * D + col0; const bf16* pp = PA + (size_t)pa[ai][m] * D + col0;
#pragma unroll
                for (int bj = 0; bj < 2; ++bj)
#pragma unroll
                    for (int n = 0; n < 2; ++n) { b[m][bj][n] = *(const f32x4*)(xp + bj * HALF + n * 16); pv[m][bj][n] = *(const u32x2*)(pp + bj * HALF + n * 16); } }
#pragma unroll
            for (int m = 2 * (am & 1); m < 2 * (am & 1) + 2; ++m) { float q = 0.f;
#pragma unroll
                for (int bj = 0; bj < 2; ++bj)
#pragma unroll
                    for (int n = 0; n < 2; ++n) { const u32x2 pw = pv[m][bj][n]; const f32x4 pf = {__uint_as_float(pw.x << 16), __uint_as_float(pw.x & 0xffff0000u), __uint_as_float(pw.y << 16), __uint_as_float(pw.y & 0xffff0000u)};
                        const f32x4 v = (b[m][bj][n] + pf) + acc[ai][bj][m][n] * w[ai][m]; acc[ai][bj][m][n] = v; q += (v[0] * v[0] + v[1] * v[1]) + (v[2] * v[2] + v[3] * v[3]); }
                q += xor_lane<16>(q); { auto rr = __builtin_amdgcn_permlane32_swap(__float_as_uint(q), __float_as_uint(q), false, false); q = __uint_as_float(rr[0]) + __uint_as_float(rr[1]); }
                if (fq == 0) P[(ai * HALF + wr * 64 + m * 16 + fr) * 4 + wc] = q; } }
        asm volatile("s_waitcnt lgkmcnt(0)\n\ts_barrier" ::: "memory");
        const int row = wid * 32 + (lane & 31);
        if (lane < 32) { const float t = (P[row * 4 + 0] + P[row * 4 + 1]) + (P[row * 4 + 2] + P[row * 4 + 3]);
            __hip_atomic_store(xch + ((size_t)(u.aux * BM + row)) * 4 + u.pn, t, __ATOMIC_RELAXED, __HIP_MEMORY_SCOPE_AGENT); }
        asm volatile("s_waitcnt vmcnt(0)" ::: "memory");
        if (lane == 0) __hip_atomic_fetch_add(cnt + 16 * u.aux, 1u, RLX_AGENT);
        if (wid == 0) { unsigned sp = 0, dead = 0;
            while ((unsigned)__builtin_amdgcn_readfirstlane((int)__hip_atomic_load(cnt + 16 * u.aux, RLX_AGENT)) < 32u) { __builtin_amdgcn_s_sleep(2); if (++sp > (1u << 22)) { dead = 1; break; } }
            __builtin_amdgcn_fence(__ATOMIC_ACQUIRE, "agent");
            if (lane == 0) flag[0] = dead; }
        asm volatile("s_waitcnt vmcnt(0) lgkmcnt(0)\n\ts_barrier" ::: "memory");
        if (lane < 32) { const float* sl = xch + ((size_t)(u.aux * BM + row)) * 4;
            const float t0 = __hip_atomic_load(sl + 0, RLX_AGENT), t1 = __hip_atomic_load(sl + 1, RLX_AGENT), t2 = __hip_atomic_load(sl + 2, RLX_AGENT), t3 = __hip_atomic_load(sl + 3, RLX_AGENT);
            float rs = 1.0f / sqrtf(((t0 + t1) + (t2 + t3)) * (1.f / D) + RMS_EPS); if (flag[0]) rs = __builtin_nanf("");
            S[row] = rs; }
        asm volatile("s_waitcnt vmcnt(0) lgkmcnt(0)\n\ts_barrier" ::: "memory");
        f32x4 gv[2][2];
#pragma unroll
        for (int bj = 0; bj < 2; ++bj)
#pragma unroll
            for (int n = 0; n < 2; ++n) gv[bj][n] = *(const f32x4*)(g + col0 + bj * HALF + n * 16);
#pragma unroll
        for (int ai = 0; ai < 2; ++ai)
#pragma unroll
            for (int m = 0; m < 4; ++m) if (tok[ai][m] >= 0) { const float rs = S[ai * HALF + wr * 64 + m * 16 + fr]; float* xp = x + (size_t)tok[ai][m] * D + col0;
#pragma unroll
                for (int bj = 0; bj < 2; ++bj)
#pragma unroll
                    for (int n = 0; n < 2; ++n) *(f32x4*)(xp + bj * HALF + n * 16) = acc[ai][bj][m][n] * rs * gv[bj][n]; }
        asm volatile("s_waitcnt lgkmcnt(0)\n\ts_barrier" ::: "memory");
    }
};

template <class Epi, class Sched, bool ALIGN_EPI>
__device__ __forceinline__ void gemm_phase(LAS unsigned char* lds, const Sched& S, const Epi& E) {
    int tid_ = threadIdx.x; asm volatile("" : "+v"(tid_));
    const int tid = tid_, wid = __builtin_amdgcn_readfirstlane(tid >> 6), lane = tid & 63, wr = wid >> 2, wc = wid & 3, fr = lane & 15, fq = lane >> 4;
    const int lda = S.lda, ldb = S.ldb;
    unsigned voffA[2], voffB[2];
#pragma unroll
    for (int i = 0; i < 2; ++i) { int R, C; stage_rc(tid * 16 + i * 8192, R, C); const int Rb = Epi::PERM ? ((R & ~31) + perm32(R & 31)) : R;
        voffA[i] = (unsigned)(R * lda + C) * 2u; voffB[i] = (unsigned)(Rb * ldb + C) * 2u; }
    const size_t kA = S.kA, kB = S.kB;
    const size_t hstepA = (size_t)HALF * lda * 2, hstepB = (size_t)HALF * ldb * 2;
    const unsigned ldsw = (unsigned)wid * 1024u;
    const int aoff = lds_byte(wr * 64 + fr, fq * 8), boff = lds_byte(wc * 32 + fr, fq * 8);
#define PG8_SA(b, h) (((b) * 2 + (h)) * HTB)
#define PG8_SB(b, h) ((4 + (b) * 2 + (h)) * HTB)
#define PG8_STAGE(bufoff, gbase, voff) do { _Pragma("unroll") for (int _i = 0; _i < 2; ++_i) \
        __builtin_amdgcn_global_load_lds((const unsigned*)((const char*)(gbase) + (voff)[_i]), (LAS unsigned*)(lds + (bufoff) + ldsw + _i * 8192), 16, 0, 0); } while (0)
#define PG8_LDA(dst, b, h) do { _Pragma("unroll") for (int m = 0; m < 4; ++m) _Pragma("unroll") for (int k = 0; k < 2; ++k) dst[m][k] = *(const LAS bf16x8*)(lds + PG8_SA(b, h) + aoff + m * 2048 + k * 1024); } while (0)
#define PG8_LDB(dst, b, h) do { _Pragma("unroll") for (int n = 0; n < 2; ++n) _Pragma("unroll") for (int k = 0; k < 2; ++k) dst[n][k] = *(const LAS bf16x8*)(lds + PG8_SB(b, h) + boff + n * 2048 + k * 1024); } while (0)
#define PG8_MMA(ai, bj, At, Bt) do { __builtin_amdgcn_s_setprio(1); _Pragma("unroll") for (int m = 0; m < 4; ++m) _Pragma("unroll") for (int n = 0; n < 2; ++n) _Pragma("unroll") for (int k = 0; k < 2; ++k) \
        acc[ai][bj][m][n] = __builtin_amdgcn_mfma_f32_16x16x32_bf16(Bt[n][k], At[m][k], acc[ai][bj][m][n], 0, 0, 0); __builtin_amdgcn_s_setprio(0); } while (0)
#define PG8_WAIT_V(n) asm volatile("s_waitcnt vmcnt(" #n ")" ::: "memory")
#define PG8_WAIT_L(n) asm volatile("s_waitcnt lgkmcnt(" #n ")" ::: "memory")
#define PG8_BAR __builtin_amdgcn_s_barrier()
#define PG8_SCHED __builtin_amdgcn_sched_barrier(0)
    Unit cur, nxt; int ui = 0;
    if (!S.next(0, cur)) return;
    f32x4 acc[2][2][4][2];
#pragma unroll
    for (int a = 0; a < 2; ++a)
#pragma unroll
        for (int b = 0; b < 2; ++b)
#pragma unroll
            for (int m = 0; m < 4; ++m)
#pragma unroll
                for (int n = 0; n < 2; ++n) acc[a][b][m][n] = (f32x4){0.f, 0.f, 0.f, 0.f};
    bf16x8 At[4][2], B0[2][2], B1[2][2];
    const char* cA = S.aptr(cur); const char* cB = S.bptr(cur);
    PG8_STAGE(PG8_SB(0, 0), cB, voffB); PG8_STAGE(PG8_SB(0, 1), cB + hstepB, voffB); PG8_STAGE(PG8_SA(0, 0), cA, voffA); PG8_STAGE(PG8_SA(0, 1), cA + hstepA, voffA);
    if (wr == 1) PG8_BAR;
    PG8_WAIT_V(2); PG8_BAR;
    PG8_STAGE(PG8_SB(1, 0), cB + kB, voffB); PG8_STAGE(PG8_SA(1, 0), cA + kA, voffA); PG8_STAGE(PG8_SB(1, 1), cB + hstepB + kB, voffB);
    PG8_WAIT_V(6); PG8_BAR;
    for (;;) {
        const bool has_next = S.next(ui + 1, nxt);
        const char* nA = has_next ? S.aptr(nxt) : cA; const char* nB = has_next ? S.bptr(nxt) : cB;
        const int nt = S.nt(cur);
        for (int t = 0; t < nt; t += 2) {
            const bool last = (t == nt - 2);
            const char* a1 = cA + (size_t)(t + 1) * kA;
            const char* a2 = last ? nA : cA + (size_t)(t + 2) * kA; const char* b2 = last ? nB : cB + (size_t)(t + 2) * kB;
            const char* a3 = a2 + kA; const char* b3 = b2 + kB;
            PG8_LDB(B0, 0, 0); PG8_LDB(B1, 0, 1); PG8_SCHED; PG8_LDA(At, 0, 0); PG8_STAGE(PG8_SA(1, 1), a1 + hstepA, voffA);
            PG8_WAIT_V(8); PG8_WAIT_L(0); PG8_BAR; PG8_MMA(0, 0, At, B0); PG8_MMA(0, 1, At, B1); PG8_BAR; PG8_SCHED;
            PG8_LDA(At, 0, 1); PG8_STAGE(PG8_SB(0, 0), b2, voffB); PG8_STAGE(PG8_SB(0, 1), b2 + hstepB, voffB); PG8_STAGE(PG8_SA(0, 0), a2, voffA);
            PG8_WAIT_V(8); PG8_WAIT_L(0); PG8_BAR; PG8_MMA(1, 0, At, B0); PG8_MMA(1, 1, At, B1); PG8_BAR; PG8_SCHED;
            PG8_LDB(B0, 1, 0); PG8_LDB(B1, 1, 1); PG8_SCHED; PG8_LDA(At, 1, 0); PG8_STAGE(PG8_SA(0, 1), a2 + hstepA, voffA);
            PG8_WAIT_V(8); PG8_WAIT_L(0); PG8_BAR; PG8_MMA(0, 0, At, B0); PG8_MMA(0, 1, At, B1); PG8_BAR; PG8_SCHED;
            PG8_LDA(At, 1, 1); PG8_STAGE(PG8_SB(1, 0), b3, voffB); PG8_STAGE(PG8_SB(1, 1), b3 + hstepB, voffB); PG8_STAGE(PG8_SA(1, 0), a3, voffA);
            PG8_WAIT_V(8); PG8_WAIT_L(0); PG8_BAR; PG8_MMA(1, 0, At, B0); PG8_MMA(1, 1, At, B1); PG8_BAR; PG8_SCHED;
        }
        if constexpr (ALIGN_EPI) { if (wr == 0) PG8_BAR; }
        E(acc, cur, wr, wc, fr, fq);
        if (!has_next) break;
        if (!E.keep(cur)) {
#pragma unroll
            for (int a = 0; a < 2; ++a)
#pragma unroll
                for (int b = 0; b < 2; ++b)
#pragma unroll
                    for (int m = 0; m < 4; ++m)
#pragma unroll
                        for (int n = 0; n < 2; ++n) acc[a][b][m][n] = (f32x4){0.f, 0.f, 0.f, 0.f};
        }
        cur = nxt; cA = nA; cB = nB; ++ui;
        if constexpr (ALIGN_EPI) { if (wr == 1) PG8_BAR; }
    }
    PG8_WAIT_V(0);
    if constexpr (!ALIGN_EPI) { if (wr == 0) PG8_BAR; }
    PG8_BAR;
#undef PG8_SA
#undef PG8_SB
#undef PG8_STAGE
#undef PG8_LDA
#undef PG8_LDB
#undef PG8_MMA
#undef PG8_WAIT_V
#undef PG8_WAIT_L
#undef PG8_BAR
#undef PG8_SCHED
}
}

constexpr int BM_ROWS = 256;
template <int MAP>
__device__ __forceinline__ void convert_job(const float* W, int K, int N, bf16* WT, int dpitch, int dcol0, LAS float* scr, int gw, int NGW, int lane, const bool tiled = false, const float scale = 1.f) {
    const int nblk = N / 32, nitems = (K / 64) * nblk;
    float v[32];
    int it = gw;
    if (it < nitems) { const float* src = W + (size_t)(64 * (it / nblk) + (lane >> 5)) * N + 32 * (it % nblk) + (lane & 31);
#pragma unroll
        for (int i = 0; i < 32; ++i) v[i] = src[(size_t)(2 * i) * N]; }
    for (; it < nitems; it += NGW) {
        const int kb = it / nblk, nb = it % nblk, k0 = 64 * kb, n0 = 32 * nb;
        int drow0 = n0;
        if (MAP == 1) { if (n0 < NQKV) { const int q = (n0 & 255) >> 5; drow0 = (n0 & ~255) + 128 * (q & 1) + 32 * (q >> 1); } }
        if (MAP == 2) drow0 = 256 * (n0 >> 7) + (n0 & 127);
        if (MAP == 3) drow0 = 256 * (n0 >> 7) + 128 + (n0 & 127);
#pragma unroll
        for (int i = 0; i < 32; ++i) scr[(2 * i + (lane >> 5)) * 33 + (lane & 31)] = v[i];
        const int nx = it + NGW;
        if (nx < nitems) { const float* src = W + (size_t)(64 * (nx / nblk) + (lane >> 5)) * N + 32 * (nx % nblk) + (lane & 31);
#pragma unroll
            for (int i = 0; i < 32; ++i) v[i] = src[(size_t)(2 * i) * N]; }
        asm volatile("s_waitcnt lgkmcnt(0)" ::: "memory");
        const int c = lane & 7;
#pragma unroll
        for (int j = 0; j < 4; ++j) { const int n = (lane >> 3) + 8 * j; const LAS float* s = scr + (8 * c) * 33 + n;
            const float sc = (MAP == 1) ? (n0 >= NQKV ? 1.4426950408889634f : 1.f) : scale;
            u32x4 o; o.x = pk2(s[0 * 33] * sc, s[1 * 33] * sc); o.y = pk2(s[2 * 33] * sc, s[3 * 33] * sc); o.z = pk2(s[4 * 33] * sc, s[5 * 33] * sc); o.w = pk2(s[6 * 33] * sc, s[7 * 33] * sc);
            const int dr = drow0 + n;
            if (tiled) *(u32x4*)(WT + (((size_t)(dr >> 8) * (K >> 6) + kb) * BM_ROWS + (dr & 255)) * 64 + 8 * c) = o;
            else *(u32x4*)(WT + (size_t)dr * dpitch + dcol0 + k0 + 8 * c) = o; }
        asm volatile("s_waitcnt lgkmcnt(0)" ::: "memory");
    }
}

template <bool ROUTER>
__device__ __forceinline__ void norm_phase(const float* x, const float* g, bf16* H, const float* wr, int* tk_e, float* tk_w, LAS unsigned* lcnt) {
    int t_ = threadIdx.x; asm volatile("" : "+v"(t_)); const int lane = t_ & 63, wave = __builtin_amdgcn_readfirstlane(t_ >> 6); (void)lane; (void)wave;
    const int gw = blockIdx.x * NWAVES + wave, NGW = gridDim.x * NWAVES;
    f32x4 gv[4];
#pragma unroll
    for (int j = 0; j < 4; ++j) gv[j] = *((const f32x4*)g + lane + 64 * j);
    f32x4 rw[ROUTER ? 16 : 1][2];
    if (ROUTER) {
#pragma unroll
        for (int j = 0; j < 4; ++j)
#pragma unroll
            for (int c = 0; c < 4; ++c) { const float* w = wr + (size_t)(256 * j + 4 * lane + c) * NEXP; rw[j * 4 + c][0] = *(const f32x4*)w; rw[j * 4 + c][1] = *(const f32x4*)(w + 4); } }
    f32x4 v[4], vn[4];
    if (gw < M) {
#pragma unroll
        for (int j = 0; j < 4; ++j) v[j] = ((const f32x4*)(x + (size_t)gw * D) + lane)[64 * j]; }
    for (int m = gw; m < M; m += NGW) {
        if (m + NGW < M) {
#pragma unroll
            for (int j = 0; j < 4; ++j) vn[j] = ((const f32x4*)(x + (size_t)(m + NGW) * D) + lane)[64 * j]; }
        float s = 0.f;
#pragma unroll
        for (int j = 0; j < 4; ++j) s += (v[j].x * v[j].x + v[j].y * v[j].y) + (v[j].z * v[j].z + v[j].w * v[j].w);
        const float rstd = 1.0f / sqrtf(wave_sum(s) * (1.f / D) + RMS_EPS);
#pragma unroll
        for (int j = 0; j < 4; ++j) v[j] = v[j] * rstd * gv[j];
        u32x2* o = (u32x2*)(H + (size_t)m * D) + lane;
#pragma unroll
        for (int j = 0; j < 4; ++j) { u32x2 w; w.x = pk2(v[j].x, v[j].y); w.y = pk2(v[j].z, v[j].w); o[64 * j] = w; }
        if (ROUTER) {
            float lg[NEXP];
#pragma unroll
            for (int e = 0; e < NEXP; ++e) lg[e] = 0.f;
#pragma unroll
            for (int j = 0; j < 4; ++j)
#pragma unroll
                for (int c = 0; c < 4; ++c) { const f32x4 w0 = rw[j * 4 + c][0], w1 = rw[j * 4 + c][1];
                    const float hv = v[j][c];
                    lg[0] = fmaf(hv, w0.x, lg[0]); lg[1] = fmaf(hv, w0.y, lg[1]); lg[2] = fmaf(hv, w0.z, lg[2]); lg[3] = fmaf(hv, w0.w, lg[3]);
                    lg[4] = fmaf(hv, w1.x, lg[4]); lg[5] = fmaf(hv, w1.y, lg[5]); lg[6] = fmaf(hv, w1.z, lg[6]); lg[7] = fmaf(hv, w1.w, lg[7]); }
#pragma unroll
            for (int e = 0; e < NEXP; ++e) lg[e] = wave_sum(lg[e]);
            int i0 = 0; float v0 = lg[0];
#pragma unroll
            for (int e = 1; e < NEXP; ++e) if (lg[e] > v0) { v0 = lg[e]; i0 = e; }
            int i1 = -1; float v1 = -INFINITY;
#pragma unroll
            for (int e = 0; e < NEXP; ++e) if (e != i0 && lg[e] > v1) { v1 = lg[e]; i1 = e; }
            const float w0 = 1.f / (1.f + expf(v1 - v0)), w1 = 1.f - w0;
            const int lo = i0 < i1 ? i0 : i1, hi = i0 < i1 ? i1 : i0;
            if (lane == 0) { tk_e[m] = lo | (hi << 8); tk_w[2 * m] = i0 < i1 ? w0 : w1; tk_w[2 * m + 1] = i0 < i1 ? w1 : w0;
                __hip_atomic_fetch_add(&lcnt[lo], 1u, __ATOMIC_RELAXED, __HIP_MEMORY_SCOPE_WORKGROUP); __hip_atomic_fetch_add(&lcnt[8 + hi], 1u, __ATOMIC_RELAXED, __HIP_MEMORY_SCOPE_WORKGROUP); }
        }
#pragma unroll
        for (int j = 0; j < 4; ++j) v[j] = vn[j];
    }
}
__device__ __forceinline__ void final_norm_phase(float* x, const float* g, int, int) {
    int t_ = threadIdx.x; asm volatile("" : "+v"(t_)); const int lane = t_ & 63, wave = __builtin_amdgcn_readfirstlane(t_ >> 6); (void)lane; (void)wave;
    const int gw = blockIdx.x * NWAVES + wave, NGW = gridDim.x * NWAVES;
    f32x4 gv[4];
#pragma unroll
    for (int j = 0; j < 4; ++j) gv[j] = *((const f32x4*)g + lane + 64 * j);
    f32x4 v[4], vn[4];
    if (gw < M) {
#pragma unroll
        for (int j = 0; j < 4; ++j) v[j] = ((const f32x4*)(x + (size_t)gw * D) + lane)[64 * j]; }
    for (int m = gw; m < M; m += NGW) {
        if (m + NGW < M) {
#pragma unroll
            for (int j = 0; j < 4; ++j) vn[j] = ((const f32x4*)(x + (size_t)(m + NGW) * D) + lane)[64 * j]; }
        f32x4* xr = (f32x4*)(x + (size_t)m * D) + lane; float s = 0.f;
#pragma unroll
        for (int j = 0; j < 4; ++j) s += (v[j].x * v[j].x + v[j].y * v[j].y) + (v[j].z * v[j].z + v[j].w * v[j].w);
        const float rstd = 1.0f / sqrtf(wave_sum(s) * (1.f / D) + RMS_EPS);
#pragma unroll
        for (int j = 0; j < 4; ++j) xr[64 * j] = v[j] * rstd * gv[j];
#pragma unroll
        for (int j = 0; j < 4; ++j) v[j] = vn[j];
    }
}
__device__ __forceinline__ void moe_dispatch_phase(LAS unsigned char* lds, const bf16* H, bf16* Hs, const int* tk_e, const float* tk_w, int* tokrow, float* wrow, gu32* ctl, int* tokposA) {
    int t_ = threadIdx.x; asm volatile("" : "+v"(t_)); const int tid = t_;
    LAS int* elo = (LAS int*)lds; LAS int* ehi = elo + 128; LAS int* posA = ehi + 128; LAS int* posB = posA + 128; LAS int* base = posB + 128; LAS int* seg = base + 16;
    if (tid < 16) { int s = 0;
#pragma unroll
        for (int e = 0; e < 7; ++e) { const int c_ = (int)((__hip_atomic_load(ctl + CW_CNT + (tid & 8) + e, RLX_AGENT) + 255u) & ~255u); s += e < (tid & 7) ? c_ : 0; }
        seg[tid] = s; }
    for (int ch = blockIdx.x; ch < M / 128; ch += gridDim.x) {
        __syncthreads();
        u32x4 v0[16];
#pragma unroll
        for (int q = 0; q < 16; ++q) v0[q] = *((const u32x4*)(H + (size_t)(ch * 128 + (tid >> 7) + 4 * q) * D) + (tid & 127));
        if (tid < 128) { const int e = tk_e[ch * 128 + tid]; elo[tid] = e & 255; ehi[tid] = e >> 8; }
        __syncthreads();
        int rA = 0, rB = 0;
        if (tid < 128) { const int lo = elo[tid], hi = ehi[tid]; for (int j = 0; j < tid; ++j) { rA += (elo[j] == lo); rB += (ehi[j] == hi); } }
        if (tid >= 128 && tid < 144) { const int k = tid - 128; int c = 0; for (int j = 0; j < 128; ++j) c += ((k < 8 ? elo[j] : ehi[j]) == (k & 7)); base[k] = (int)__hip_atomic_fetch_add(ctl + CW_FILL + k, (unsigned)c, RLX_AGENT); }
        __syncthreads();
        if (tid < 128) { const int tok = ch * 128 + tid, lo = elo[tid], hi = ehi[tid];
            const int pA = seg[lo] + base[lo] + rA, pB = MOE_LROWS + seg[8 + hi] + base[8 + hi] + rB;
            tokrow[pA] = tok; wrow[pA] = tk_w[2 * tok]; tokrow[pB] = tok; wrow[pB] = tk_w[2 * tok + 1]; posA[tid] = pA; posB[tid] = pB; tokposA[tok] = pA; }
        __syncthreads();
        { u32x4 v1[16];
          const int j0 = tid >> 7;
#pragma unroll
          for (int q = 0; q < 16; ++q) v1[q] = *((const u32x4*)(H + (size_t)(ch * 128 + 64 + j0 + 4 * q) * D) + (tid & 127));
#pragma unroll
          for (int q = 0; q < 16; ++q) { const int j = j0 + 4 * q; *((u32x4*)(Hs + (size_t)posA[j] * D) + (tid & 127)) = v0[q]; *((u32x4*)(Hs + (size_t)posB[j] * D) + (tid & 127)) = v0[q]; }
#pragma unroll
          for (int q = 0; q < 16; ++q) { const int j = 64 + j0 + 4 * q; *((u32x4*)(Hs + (size_t)posA[j] * D) + (tid & 127)) = v1[q]; *((u32x4*)(Hs + (size_t)posB[j] * D) + (tid & 127)) = v1[q]; } }
    }
    __syncthreads();
}


__device__ __forceinline__ void moe_router_phase(LAS unsigned char* lds, const float* X, const float* nf, bf16* H, const float* w_router, const float* wg, const float* wu, const float* wd,
                                                 int* tk_e, float* tk_w, int* tokrow, unsigned char* ws, gu32* ctl) {
    int t_ = threadIdx.x; asm volatile("" : "+v"(t_)); const int tid = t_, lane = tid & 63, wave = __builtin_amdgcn_readfirstlane(tid >> 6);
    int G_ = gridDim.x; asm volatile("" : "+s"(G_)); const int G = G_, bid = blockIdx.x;
    LAS unsigned* lcnt = (LAS unsigned*)lds;
    if (tid < 16) lcnt[tid] = 0u;
    __syncthreads();
    norm_phase<true>(X, nf, H, w_router, tk_e, tk_w, lcnt);
    __syncthreads();
    if (tid < 16) __hip_atomic_fetch_add(ctl + CW_CNT + tid, lcnt[tid], RLX_AGENT);
    for (int i = bid * NTHREADS + tid; i < 2 * MOE_LROWS; i += G * NTHREADS) tokrow[i] = -1;
    __syncthreads();
    LAS float* scr = (LAS float*)(lds + wave * 16384);
    const int gw = bid * NWAVES + wave, NGW = G * NWAVES;
    for (int e = 0; e < NEXP; ++e) {
        bf16* gu = (bf16*)(ws + WS_EXPW) + (size_t)e * 2 * FFE * D; bf16* dn = (bf16*)(ws + WS_EXPW + EXPW_DN) + (size_t)e * D * FFE;
        const int g0 = (gw + NGW - ((3 * e) * 1792) % NGW) % NGW, g1 = (gw + NGW - ((3 * e + 1) * 1792) % NGW) % NGW, g2 = (gw + NGW - ((3 * e + 2) * 1792) % NGW) % NGW;
        convert_job<2>(wg + (size_t)e * D * FFE, D, FFE, gu, D, 0, scr, g0, NGW, lane, false, 1.4426950408889634f);
        convert_job<3>(wu + (size_t)e * D * FFE, D, FFE, gu, D, 0, scr, g1, NGW, lane, false, 0.6931471805599453f);
        convert_job<0>(wd + (size_t)e * FFE * D, FFE, D, dn, FFE, 0, scr, g2, NGW, lane, true); }
}

namespace attn_body {
typedef short bf16x8 __attribute__((ext_vector_type(8)));
typedef short s16x4 __attribute__((ext_vector_type(4)));
typedef float f32x16 __attribute__((ext_vector_type(16)));
constexpr int NW = 8, QBLK = 32, QB = QBLK * NW, KVBLK = 64, PITCH = 64;
__device__ __forceinline__ int crow(int r, int hi) { return (r & 3) + 8 * (r >> 2) + 4 * hi; }
#define SBAR() __builtin_amdgcn_sched_barrier(0)
__device__ __forceinline__ void cmask(f32x16& p0, f32x16& p1, int jb, int qrel, int hi) {
    const float NEG = -INFINITY; int kb = 64 * jb + 4 * hi;
#pragma unroll
    for (int r = 0; r < 16; ++r) { int kv = kb + (r & 3) + 8 * (r >> 2); if (kv > qrel) p0[r] = NEG; if (kv + 32 > qrel) p1[r] = NEG; }
}
__device__ __forceinline__ void dmask(f32x16& p0, f32x16& p1, int tmp, unsigned wq) {
    const float NEG = -INFINITY;
#pragma unroll
    for (int r = 0; r < 16; ++r) { const int off = (r & 3) + 8 * (r >> 2); if ((unsigned)(tmp - off) > wq) p0[r] = NEG; if ((unsigned)(tmp - off - 32) > wq) p1[r] = NEG; }
}
constexpr int NSLOT = 3, SLOTB = 8192;
constexpr int LDS_K = 0, LDS_V = NSLOT * SLOTB, LDS_WS = 2 * NSLOT * SLOTB, LDS_OST = LDS_WS + NW * 64 * 4, LDS_BYTES = LDS_OST + NW * 4096;
constexpr float C2 = 0.125f * 1.4426950408889634f;
__device__ __forceinline__ void glds16(const void* gsrc, unsigned lds_dst) { unsigned keep;
    asm volatile("s_mov_b32 %0, m0\n\ts_mov_b32 m0, %2\n\ts_nop 0\n\tglobal_load_lds_dwordx4 %1, off\n\ts_mov_b32 m0, %0" : "=&s"(keep) : "v"(gsrc), "s"(lds_dst) : "memory"); }
__device__ __forceinline__ float max3f(float a, float b, float c) { float r; asm("v_max3_f32 %0, %1, %2, %3" : "=v"(r) : "v"(a), "v"(b), "v"(c)); return r; }
__device__ __forceinline__ float max2f(float a, float b) { float r; asm("v_max_f32_e32 %0, %1, %2" : "=v"(r) : "v"(a), "v"(b)); return r; }
__device__ __forceinline__ float fadd_s(float a, float b) { float r; asm("v_add_f32_e32 %0, %1, %2" : "=v"(r) : "v"(a), "v"(b)); return r; }
__device__ __forceinline__ float fsub_s(float a, float b) { float r; asm("v_sub_f32_e32 %0, %1, %2" : "=v"(r) : "v"(a), "v"(b)); return r; }
typedef float f32x2_t __attribute__((ext_vector_type(2))); typedef __bf16 bf16x2_t __attribute__((ext_vector_type(2)));
__device__ __forceinline__ unsigned cvtpk_s(float lo, float hi) { f32x2_t v = {lo, hi}; bf16x2_t b = __builtin_convertvector(v, bf16x2_t); return __builtin_bit_cast(unsigned, b); }
#define WAIT_BAR(N) asm volatile("s_waitcnt vmcnt(" #N ") lgkmcnt(0)\n\ts_barrier" ::: "memory")
__device__ __forceinline__ void qkt(f32x16& p0, f32x16& p1, const char* Kslot, const bf16x8* qr, const f32x16& negm, int r32, int hi) {
    const char* kb = Kslot + hi * 1024 + r32 * 16;
#pragma unroll
    for (int d0 = 0; d0 < 4; ++d0) {
        const bf16x8 b0 = *reinterpret_cast<const bf16x8*>(kb + d0 * 2048);
        const bf16x8 b1 = *reinterpret_cast<const bf16x8*>(kb + d0 * 2048 + 512);
        if (d0 == 0) { p0 = __builtin_amdgcn_mfma_f32_32x32x16_bf16(b0, qr[0], negm, 0, 0, 0); p1 = __builtin_amdgcn_mfma_f32_32x32x16_bf16(b1, qr[0], negm, 0, 0, 0); }
        else { p0 = __builtin_amdgcn_mfma_f32_32x32x16_bf16(b0, qr[d0], p0, 0, 0, 0); p1 = __builtin_amdgcn_mfma_f32_32x32x16_bf16(b1, qr[d0], p1, 0, 0, 0); } }
}
typedef __attribute__((address_space(3))) const char* lds_cptr;
typedef short v4i16_t __attribute__((ext_vector_type(4)));
__device__ __forceinline__ void kload8(bf16x8* kf, lds_cptr kp) {
    kf[0] = *(const __attribute__((address_space(3))) bf16x8*)(kp);        kf[1] = *(const __attribute__((address_space(3))) bf16x8*)(kp + 512);
    kf[2] = *(const __attribute__((address_space(3))) bf16x8*)(kp + 2048); kf[3] = *(const __attribute__((address_space(3))) bf16x8*)(kp + 2560);
    kf[4] = *(const __attribute__((address_space(3))) bf16x8*)(kp + 4096); kf[5] = *(const __attribute__((address_space(3))) bf16x8*)(kp + 4608);
    kf[6] = *(const __attribute__((address_space(3))) bf16x8*)(kp + 6144); kf[7] = *(const __attribute__((address_space(3))) bf16x8*)(kp + 6656);
}
__device__ __forceinline__ void kload2(bf16x8* kf, lds_cptr kp, int j) { kf[2 * j] = *(const __attribute__((address_space(3))) bf16x8*)(kp + j * 2048); kf[2 * j + 1] = *(const __attribute__((address_space(3))) bf16x8*)(kp + j * 2048 + 512); }
__device__ __forceinline__ s16x4 vtr(lds_cptr p) { return __builtin_bit_cast(s16x4, __builtin_amdgcn_ds_read_tr16_b64_v4i16((__attribute__((address_space(3))) v4i16_t*)p)); }
__device__ __forceinline__ float rowmax(const f32x16& p0, const f32x16& p1) {
    float a = max3f(p0[0], p0[1], p1[0]), b = max3f(p0[2], p0[3], p1[1]); a = max3f(a, p1[2], p1[3]);
#pragma unroll
    for (int r = 4; r < 16; r += 4) { a = max3f(a, p0[r], p0[r + 1]); b = max3f(b, p0[r + 2], p0[r + 3]); a = max3f(a, p1[r], p1[r + 1]); b = max3f(b, p1[r + 2], p1[r + 3]); }
    const float m = max2f(a, b);
    auto rr = __builtin_amdgcn_permlane32_swap(__float_as_uint(m), __float_as_uint(m), false, false);
    return max2f(__uint_as_float(rr[0]), __uint_as_float(rr[1]));
}
__device__ __forceinline__ void pv(f32x16* o, int vb, bf16x8 pa0, bf16x8 pa1, bf16x8 pa2, bf16x8 pa3) {
#pragma unroll
    for (int d0 = 0; d0 < 2; ++d0) { s16x4 lo[4], hi[4];
#pragma unroll
        for (int ks = 0; ks < 4; ++ks) {
            asm volatile("ds_read_b64_tr_b16 %0,%1 offset:%c2" : "=&v"(lo[ks]) : "v"(vb), "i"(d0 * 4096 + ks * 1024) : "memory");
            asm volatile("ds_read_b64_tr_b16 %0,%1 offset:%c2" : "=&v"(hi[ks]) : "v"(vb), "i"(d0 * 4096 + ks * 1024 + 512) : "memory"); }
        asm volatile("s_waitcnt lgkmcnt(0)" ::: "memory"); SBAR();
#define PK(k) (bf16x8){lo[k][0], lo[k][1], lo[k][2], lo[k][3], hi[k][0], hi[k][1], hi[k][2], hi[k][3]}
        o[d0] = __builtin_amdgcn_mfma_f32_32x32x16_bf16(pa0, PK(0), o[d0], 0, 0, 0);
        o[d0] = __builtin_amdgcn_mfma_f32_32x32x16_bf16(pa1, PK(1), o[d0], 0, 0, 0);
        o[d0] = __builtin_amdgcn_mfma_f32_32x32x16_bf16(pa2, PK(2), o[d0], 0, 0, 0);
        o[d0] = __builtin_amdgcn_mfma_f32_32x32x16_bf16(pa3, PK(3), o[d0], 0, 0, 0);
#undef PK
    }
}
struct UnitP {
    const bf16* Q; const bf16* K; const bf16* V; bf16* O;
    long rbase; int rstride, rsplit, vmask, vshift;
    int q0, T0, NT;
    int wqmode;
    const float* km; int qb;
    float* lse;
};
template <int KIND, int THRL, int NS = 3>
__device__ __forceinline__ void attn_unit(const UnitP& P, char* shm) {
    int t_ = threadIdx.x; asm volatile("" : "+v"(t_));
    const int tid = t_, lane = tid & 63, r32 = lane & 31, hi = lane >> 5; const int wid = __builtin_amdgcn_readfirstlane(tid >> 6);
    const int q0 = P.q0, T0 = P.T0, NT = P.NT;
#define VROW(v) (P.rbase + (long)((v) & P.vmask) * P.rstride + (long)((v) >> P.vshift) * P.rsplit)
    constexpr int OFFV = KIND == 1 ? 6 * SLOTB : LDS_V, OFFWS = KIND == 1 ? 12 * SLOTB : LDS_WS, OFFOST = OFFWS + NW * 64 * 4;
    static_assert(12 * SLOTB + NW * 64 * 4 + NW * 4096 <= MISC_OFF, "dilated-unit LDS layout");
    const unsigned lds0 = (unsigned)(uintptr_t)shm;
    float* wsf = (float*)(shm + OFFWS) + wid * 64;
    const unsigned kdst = lds0 + LDS_K + wid * 1024, vdst = lds0 + OFFV + wid * 1024;
#define DMA_K(t, slot) glds16(P.K + VROW((T0 + (t)) * KVBLK + lane) * PITCH + wid * 8, (unsigned)__builtin_amdgcn_readfirstlane(kdst + (slot)))
#define DMA_V(t, slot) glds16(P.V + VROW((T0 + (t)) * KVBLK + 16 * (wid & 3) + (lane >> 2)) * PITCH + (wid >> 2) * 32 + (lane & 3) * 8, (unsigned)__builtin_amdgcn_readfirstlane(vdst + (slot)))
    const int vb0 = (int)(lds0 + OFFV) + ((lane >> 4) & 1) * 32 + (lane & 3) * 8 + (4 * hi + ((lane & 15) >> 2)) * 64;
    const char* Kbase = shm + LDS_K; bf16x8 kf[8];
    const lds_cptr shm3 = (lds_cptr)shm; const lds_cptr kp0 = shm3 + LDS_K + hi * 1024 + r32 * 16; const lds_cptr vp0 = shm3 + OFFV + ((lane >> 4) & 1) * 32 + (lane & 3) * 8 + (4 * hi + ((lane & 15) >> 2)) * 64;
    const int qrel = wid * QBLK + r32, qv = q0 + qrel;
    bf16x8 qr[4];
    { const bf16* Qw = P.Q + VROW(qv) * PITCH;
#pragma unroll
      for (int d0 = 0; d0 < 4; ++d0) qr[d0] = *reinterpret_cast<const bf16x8*>(&Qw[d0 * 16 + hi * 8]); }
    unsigned wq = 128u; if (KIND == 1 && P.wqmode) wq = (unsigned)(qv & 127);
    if (KIND == 1) {
#pragma unroll
        for (int t = 0; t < 6; ++t) if (t < NT) { DMA_K(t, t * SLOTB); DMA_V(t, t * SLOTB); }
    } else { DMA_K(0, 0); DMA_V(0, 0); DMA_K(1, SLOTB); }
    unsigned sel = 0xffffffffu;
    if (KIND == 0) {
        const int qb = P.qb;
        if (qb > 0) {
            float* tbl = (float*)(shm + OFFOST);
            if (tid < 128) *(f32x4*)(tbl + tid * 4) = *(const f32x4*)(P.km + (size_t)(tid >> 4) * WA + (tid & 15) * 4);
            asm volatile("s_waitcnt vmcnt(0) lgkmcnt(0)\n\ts_barrier" ::: "memory");
            float qf[32];
#pragma unroll
            for (int d0 = 0; d0 < 4; ++d0)
#pragma unroll
                for (int i = 0; i < 8; ++i) qf[d0 * 8 + i] = __uint_as_float(((unsigned)(unsigned short)qr[d0][i]) << 16);
            float g[7];
#pragma unroll
            for (int j = 0; j < 7; ++j) { float s = 0.f;
                if (j < qb) {
#pragma unroll
                    for (int d0 = 0; d0 < 4; ++d0) { const f32x4 k0 = *(const f32x4*)(tbl + j * 64 + d0 * 16 + hi * 8), k1 = *(const f32x4*)(tbl + j * 64 + d0 * 16 + hi * 8 + 4);
                        s += qf[d0 * 8 + 0] * k0[0] + qf[d0 * 8 + 1] * k0[1] + qf[d0 * 8 + 2] * k0[2] + qf[d0 * 8 + 3] * k0[3] + qf[d0 * 8 + 4] * k1[0] + qf[d0 * 8 + 5] * k1[1] + qf[d0 * 8 + 6] * k1[2] + qf[d0 * 8 + 7] * k1[3]; }
                    { auto rr = __builtin_amdgcn_permlane32_swap(__float_as_uint(s), __float_as_uint(s), false, false); s = __uint_as_float(rr[0]) + __uint_as_float(rr[1]); } }
                g[j] = s; }
            sel = 0u; const int nsel = qb < MOBA_TOPK ? qb : MOBA_TOPK;
#pragma unroll
            for (int k = 0; k < MOBA_TOPK; ++k) if (k < nsel) { int best = -1; float bv = -INFINITY;
#pragma unroll
                for (int j = 0; j < 7; ++j) if (j < qb && !((sel >> j) & 1u) && (best < 0 || g[j] > bv)) { bv = g[j]; best = j; }
                sel |= 1u << best; }
            sel |= 1u << qb;
            asm volatile("s_waitcnt lgkmcnt(0)\n\ts_barrier" ::: "memory");
        }
    }
    float zz_ = 0.f; asm volatile("" : "+v"(zz_));
    float mhat = 0.f, l_reg = 0.f; f32x16 o[2]; f32x16 negm;
#pragma unroll
    for (int r = 0; r < 16; ++r) { o[0][r] = zz_; o[1][r] = zz_; negm[r] = zz_; }
    asm volatile("" : "+v"(negm));
#define CMASK(P0, P1, t) do { if (KIND == 0) { int jb_ = (t) - (NT - 4); if (jb_ >= 0) cmask(P0, P1, jb_, qrel, hi); } else { dmask(P0, P1, qv - 64 * (T0 + (t)) - 4 * hi, wq); } } while (0)
#define PRE(t) do { if (KIND == 0) { const float nm_ = ((sel >> ((T0 + (t)) >> 2)) & 1u) ? -mhat : -INFINITY; _Pragma("unroll") for (int r = 0; r < 16; ++r) negm[r] = nm_; asm volatile("" : "+v"(negm)); } } while (0)
    bool resc = false;
#define START(P0, P1) do { const float rm = rowmax(P0, P1); resc = false; \
    { const float dl = (rm == -INFINITY) ? 0.f : rm; mhat = fadd_s(mhat, dl); \
      _Pragma("unroll") for (int r = 0; r < 16; ++r) { P0[r] = fsub_s(P0[r], dl); P1[r] = fsub_s(P1[r], dl); } \
      _Pragma("unroll") for (int r = 0; r < 16; ++r) negm[r] = -mhat; asm volatile("" : "+v"(negm)); } \
    _Pragma("unroll") for (int r = 0; r < 16; ++r) P0[r] = __builtin_amdgcn_exp2f(P0[r]); } while (0)
#define RESC() do { if (resc) { asm volatile("s_waitcnt lgkmcnt(0)" ::: "memory"); \
      _Pragma("unroll") for (int d_ = 0; d_ < 2; ++d_) _Pragma("unroll") for (int r = 0; r < 16; ++r) o[d_][r] *= wsf[crow(r, hi)]; } } while (0)
    f32x16 pA0, pA1, pB0, pB1;
    int sl_prev = 0, sl_cur = 0, sl_next = SLOTB;
#define ROT() do { sl_prev = sl_cur; sl_cur = sl_next; sl_next = (sl_next == (NSLOT - 1) * SLOTB) ? 0 : sl_next + SLOTB; } while (0)
#define ROT1() do { sl_prev = sl_cur; sl_cur = sl_next; sl_next = sl_next + SLOTB; } while (0)
    int tl = 0;
    if (KIND == 1) {
        const int ns = NS, qw = q0 + wid * QBLK;
        int first = (P.wqmode ? ((qw & ~127) - 64 * T0) : (qw - 127 - 64 * T0)) >> 6; first = first < 0 ? 0 : first;
        tl = first < NT - ns ? first : NT - ns;
        asm volatile("s_waitcnt vmcnt(0) lgkmcnt(0)\n\ts_barrier" ::: "memory");
        sl_cur = tl * SLOTB;
        qkt(pA0, pA1, Kbase + sl_cur, qr, negm, r32, hi); asm volatile("s_nop 15\n\ts_nop 7" : "+v"(pA0), "+v"(pA1)); CMASK(pA0, pA1, tl);
        START(pA0, pA1);
        _Pragma("unroll") for (int r = 0; r < 16; ++r) pA1[r] = __builtin_amdgcn_exp2f(pA1[r]);
        sl_prev = sl_cur; sl_cur += SLOTB; sl_next = sl_cur + SLOTB;
        kload8(kf, kp0 + sl_cur);
    } else {
    DMA_K(2, 2 * SLOTB);
    WAIT_BAR(3);
    PRE(0);
    qkt(pA0, pA1, Kbase, qr, negm, r32, hi); asm volatile("s_nop 15\n\ts_nop 7" : "+v"(pA0), "+v"(pA1)); CMASK(pA0, pA1, 0);
    START(pA0, pA1);
    _Pragma("unroll") for (int r = 0; r < 16; ++r) pA1[r] = __builtin_amdgcn_exp2f(pA1[r]);
    WAIT_BAR(0);
    DMA_K(3, 0); DMA_V(1, SLOTB);
    ROT();
    kload8(kf, kp0 + sl_cur);
    WAIT_BAR(2);
    }
    s16x4 vlo[8], vhi[8]; u32x4 pw0, pw1, pw2, pw3;
#define PKW(P, B) cvtpk_s(P[B], P[B + 1])
#define PAF(k) __builtin_bit_cast(bf16x8, pw##k)
#define VFR(i) (bf16x8){vlo[i][0], vlo[i][1], vlo[i][2], vlo[i][3], vhi[i][0], vhi[i][1], vhi[i][2], vhi[i][3]}
#define PIN(x) asm volatile("" : "+v"(x))
#define MX3(a, b, c) __builtin_fmaxf(__builtin_fmaxf((a), (b)), (c))
#define GAPA(MF, A0, A1, A2, A3, W0, W1, PW) do { MF; sacc += A0; sacc += A1; sacc += A2; sacc += A3; PIN(sacc); W0; W1; PIN(PW); SBAR(); } while (0)
#define EX(v) __builtin_amdgcn_exp2f(v)
#define GAPB(MF, X, B) do { MF; X[B] = EX(X[B]); X[B + 1] = EX(X[B + 1]); X[B + 2] = EX(X[B + 2]); X[B + 3] = EX(X[B + 3]); PIN(X); SBAR(); } while (0)
#define VRD(i) do { vlo[i] = vtr(vp_ + (((i) >> 2) * 4096 + ((i) & 3) * 1024)); vhi[i] = vtr(vp_ + (((i) >> 2) * 4096 + ((i) & 3) * 1024 + 512)); } while (0)
#define KRD(G, j) do { if (G) { kload2(kf, kp0 + sl_next, j); SBAR(); } } while (0)
#define STEP(C0, C1, P0, P1, t, GK, GV, GL) do { PRE(t); SBAR(); \
    const lds_cptr vp_ = vp0 + sl_prev; \
    VRD(0); SBAR(); float sacc = (P0[0] + P0[1]); \
    GAPA(C0 = __builtin_amdgcn_mfma_f32_32x32x16_bf16(kf[0], qr[0], negm, 0, 0, 0), P0[2], P0[3], P0[4], P0[5],     pw0[0] = PKW(P0, 0), pw0[1] = PKW(P0, 2), pw0); \
    VRD(4); SBAR(); GAPA(C1 = __builtin_amdgcn_mfma_f32_32x32x16_bf16(kf[1], qr[0], negm, 0, 0, 0), P0[6], P0[7], P0[8], P0[9],     pw0[2] = PKW(P0, 4), pw0[3] = PKW(P0, 6), pw0); \
    VRD(1); SBAR(); GAPA(C0 = __builtin_amdgcn_mfma_f32_32x32x16_bf16(kf[2], qr[1], C0, 0, 0, 0),   P0[10], P0[11], P0[12], P0[13], pw1[0] = PKW(P0, 8), pw1[1] = PKW(P0, 10), pw1); \
    VRD(5); SBAR(); GAPA(C1 = __builtin_amdgcn_mfma_f32_32x32x16_bf16(kf[3], qr[1], C1, 0, 0, 0),   P0[14], P0[15], P1[0], P1[1],   pw1[2] = PKW(P0, 12), pw1[3] = PKW(P0, 14), pw1); \
    VRD(2); SBAR(); GAPA(C0 = __builtin_amdgcn_mfma_f32_32x32x16_bf16(kf[4], qr[2], C0, 0, 0, 0),   P1[2], P1[3], P1[4], P1[5],     pw2[0] = PKW(P1, 0), pw2[1] = PKW(P1, 2), pw2); \
    VRD(6); SBAR(); GAPA(C1 = __builtin_amdgcn_mfma_f32_32x32x16_bf16(kf[5], qr[2], C1, 0, 0, 0),   P1[6], P1[7], P1[8], P1[9],     pw2[2] = PKW(P1, 4), pw2[3] = PKW(P1, 6), pw2); \
    VRD(3); SBAR(); GAPA(C0 = __builtin_amdgcn_mfma_f32_32x32x16_bf16(kf[6], qr[3], C0, 0, 0, 0),   P1[10], P1[11], P1[12], P1[13], pw3[0] = PKW(P1, 8), pw3[1] = PKW(P1, 10), pw3); \
    VRD(7); SBAR(); GAPA(C1 = __builtin_amdgcn_mfma_f32_32x32x16_bf16(kf[7], qr[3], C1, 0, 0, 0),   P1[14], P1[15], 0.f, 0.f,       pw3[2] = PKW(P1, 12), pw3[3] = PKW(P1, 14), pw3); \
    l_reg += sacc; \
    if (GK) { DMA_K((t) + 3, sl_cur); } if (GV) { DMA_V((t) + 1, sl_next); } \
    CMASK(C0, C1, t); \
    { float a = MX3(C0[0], C0[1], C1[0]), b = MX3(C0[2], C0[3], C1[1]); a = MX3(a, C1[2], C1[3]); \
      _Pragma("unroll") for (int r = 4; r < 16; r += 4) { a = MX3(a, C0[r], C0[r + 1]); b = MX3(b, C0[r + 2], C0[r + 3]); a = MX3(a, C1[r], C1[r + 1]); b = MX3(b, C1[r + 2], C1[r + 3]); } \
      float rm = __builtin_fmaxf(a, b); { auto rr = __builtin_amdgcn_permlane32_swap(__float_as_uint(rm), __float_as_uint(rm), false, false); rm = __builtin_fmaxf(__uint_as_float(rr[0]), __uint_as_float(rr[1])); } \
      resc = false; \
      if (__builtin_expect(__any(rm > (float)THRL), 0)) { const float dl = __builtin_fmaxf(rm, 0.f); mhat += dl; \
        _Pragma("unroll") for (int r = 0; r < 16; ++r) { C0[r] -= dl; C1[r] -= dl; } \
        _Pragma("unroll") for (int r = 0; r < 16; ++r) negm[r] = -mhat; asm volatile("" : "+v"(negm)); \
        const float f = __builtin_amdgcn_exp2f(-dl); l_reg *= f; if (hi == 0) wsf[r32] = f; resc = true; } } \
    SBAR(); \
    GAPB(o[0] = __builtin_amdgcn_mfma_f32_32x32x16_bf16(PAF(0), VFR(0), o[0], 0, 0, 0), C0, 0); \
    GAPB(o[1] = __builtin_amdgcn_mfma_f32_32x32x16_bf16(PAF(0), VFR(4), o[1], 0, 0, 0), C0, 4); \
    KRD(GL, 0); GAPB(o[0] = __builtin_amdgcn_mfma_f32_32x32x16_bf16(PAF(1), VFR(1), o[0], 0, 0, 0), C0, 8); \
    KRD(GL, 1); GAPB(o[1] = __builtin_amdgcn_mfma_f32_32x32x16_bf16(PAF(1), VFR(5), o[1], 0, 0, 0), C0, 12); \
    KRD(GL, 2); GAPB(o[0] = __builtin_amdgcn_mfma_f32_32x32x16_bf16(PAF(2), VFR(2), o[0], 0, 0, 0), C1, 0); \
    KRD(GL, 3); GAPB(o[1] = __builtin_amdgcn_mfma_f32_32x32x16_bf16(PAF(2), VFR(6), o[1], 0, 0, 0), C1, 4); \
    GAPB(o[0] = __builtin_amdgcn_mfma_f32_32x32x16_bf16(PAF(3), VFR(3), o[0], 0, 0, 0), C1, 8); \
    GAPB(o[1] = __builtin_amdgcn_mfma_f32_32x32x16_bf16(PAF(3), VFR(7), o[1], 0, 0, 0), C1, 12); \
    } while (0)
    int t = 1;
#define ENDW(tt) do { if ((tt) + 3 < NT) { WAIT_BAR(2); } else if ((tt) + 2 < NT) { WAIT_BAR(1); } else { WAIT_BAR(0); } } while (0)
    if (KIND == 0) {
#undef CMASK
#define CMASK(P0, P1, t) do { } while (0)
        for (; t + 5 < NT; t += 2) {
            STEP(pB0, pB1, pA0, pA1, t, true, true, true);     WAIT_BAR(2); RESC(); ROT();
            STEP(pA0, pA1, pB0, pB1, t + 1, true, true, true); WAIT_BAR(2); RESC(); ROT();
        }
#undef CMASK
#define CMASK(P0, P1, t) do { if (KIND == 0) { int jb_ = (t) - (NT - 4); if (jb_ >= 0) cmask(P0, P1, jb_, qrel, hi); } else { dmask(P0, P1, qv - 64 * (T0 + (t)) - 4 * hi, wq); } } while (0)
    }
#define FINAL(Q0, Q1) do { float sacc = Q0[0] + Q0[1]; _Pragma("unroll") for (int r = 2; r < 16; ++r) sacc += Q0[r]; _Pragma("unroll") for (int r = 0; r < 16; ++r) sacc += Q1[r]; l_reg += sacc; \
      pw0 = (u32x4){PKW(Q0, 0), PKW(Q0, 2), PKW(Q0, 4), PKW(Q0, 6)}; pw1 = (u32x4){PKW(Q0, 8), PKW(Q0, 10), PKW(Q0, 12), PKW(Q0, 14)}; pw2 = (u32x4){PKW(Q1, 0), PKW(Q1, 2), PKW(Q1, 4), PKW(Q1, 6)}; pw3 = (u32x4){PKW(Q1, 8), PKW(Q1, 10), PKW(Q1, 12), PKW(Q1, 14)}; \
      SBAR(); pv(o, vb0 + sl_cur, PAF(0), PAF(1), PAF(2), PAF(3)); } while (0)
    if (KIND == 1) {
        if (NS == 2) { STEP(pB0, pB1, pA0, pA1, tl + 1, false, false, false); RESC(); FINAL(pB0, pB1); }
        else { STEP(pB0, pB1, pA0, pA1, tl + 1, false, false, true); RESC(); ROT1();
               STEP(pA0, pA1, pB0, pB1, tl + 2, false, false, false); RESC(); FINAL(pA0, pA1); }
    } else {
    for (; t + 1 < NT; t += 2) {
        STEP(pB0, pB1, pA0, pA1, t, (t + 3 < NT), (t + 1 < NT), (t + 1 < NT));         ENDW(t);     RESC(); ROT();
        STEP(pA0, pA1, pB0, pB1, t + 1, (t + 4 < NT), (t + 2 < NT), (t + 2 < NT));     ENDW(t + 1); RESC(); ROT();
    }
    STEP(pB0, pB1, pA0, pA1, NT - 1, false, false, false); RESC();
    FINAL(pB0, pB1);
    }
#undef FINAL
#undef PKW
#undef PAF
#undef VFR
#undef PIN
#undef MX3
#undef GAPA
#undef GAPB
#undef EX
#undef VRD
#undef KRD
#undef STEP
#undef ENDW
    { auto rr = __builtin_amdgcn_permlane32_swap(__float_as_uint(l_reg), __float_as_uint(l_reg), false, false); l_reg = __uint_as_float(rr[0]) + __uint_as_float(rr[1]); }
    if (hi == 0) wsf[32 + r32] = l_reg; asm volatile("s_waitcnt lgkmcnt(0)" ::: "memory");
    if (KIND == 1) { if (hi == 0) P.lse[(size_t)VROW(qv) * 4] = mhat + __builtin_amdgcn_logf(l_reg); }
    float rli[16];
#pragma unroll
    for (int r = 0; r < 16; ++r) rli[r] = __builtin_amdgcn_rcpf(wsf[32 + crow(r, hi)]);
    { bf16* stg = (bf16*)(shm + OFFOST) + wid * 2048;
#pragma unroll
      for (int r = 0; r < 16; ++r) { const int orow = crow(r, hi);
#pragma unroll
          for (int d0 = 0; d0 < 2; ++d0) stg[orow * 64 + d0 * 32 + r32] = (bf16)f2bf(o[d0][r] * rli[r]); }
      asm volatile("s_waitcnt lgkmcnt(0)" ::: "memory");
#pragma unroll
      for (int i = 0; i < 4; ++i) { const int row = i * 8 + (lane >> 3), ch = lane & 7; const u32x4 v = *(const u32x4*)(stg + row * 64 + ch * 8);
          *(u32x4*)(P.O + VROW(q0 + wid * QBLK + row) * PITCH + ch * 8) = v; } }
    asm volatile("s_waitcnt lgkmcnt(0)\n\ts_barrier" ::: "memory");
#undef DMA_K
#undef DMA_V
#undef CMASK
#undef PRE
#undef START
#undef RESC
#undef ROT
#undef ROT1
#undef VROW
}
#undef SBAR
#undef WAIT_BAR
}

template <bool DO_MOBA, bool DO_DIL>
__device__ __forceinline__ void attn_phase(char* shm, bf16* QKV, const float* KML, float* LSE) {
    const int G = gridDim.x, bx = blockIdx.x; const int vcu = (G % 8 == 0) ? (bx % 8) * (G / 8) + bx / 8 : bx;
    if (DO_DIL) for (int u = vcu; u < 1536; u += G) {
        attn_body::UnitP P; const int g = u >> 9, w = u & 511; int b, h, qb = 0, r = 0;
        if (g == 0) { qb = w & 7; b = w >> 5; h = (w >> 3) & 3; }
        else if (g == 1) { qb = w & 1; const int rest = w >> 1; b = rest >> 4; r = (rest >> 2) & 3; h = rest & 3; }
        else { b = w >> 5; r = 2 * ((w >> 2) & 7); h = w & 3; }
        const int head = 4 * g + h;
        P.Q = QKV_AT(QKV, C_QB + head * 64, 0); P.K = QKV_AT(QKV, C_KB + head * 64, 0); P.V = QKV_AT(QKV, C_VB + head * 64, 0); P.O = QKV_AT(QKV, C_QB + head * 64, 0);
        P.rbase = (long)b * SEQ + r; P.rstride = g == 0 ? 1 : (g == 1 ? 4 : 16); P.rsplit = g == 2 ? 1 : 0; P.vmask = g == 2 ? 127 : 0x7fffffff; P.vshift = g == 2 ? 7 : 31;
        P.q0 = qb * 256; P.T0 = qb == 0 ? 0 : 4 * qb - 2; P.NT = qb == 0 ? 4 : 6; P.wqmode = g == 2 ? 1 : 0; P.km = nullptr; P.qb = 0; P.lse = LSE + (size_t)g * M * 4 + h;
        if (g == 2) attn_body::attn_unit<1, 8, 2>(P, shm); else attn_body::attn_unit<1, 8, 3>(P, shm);
    }
    if (DO_MOBA) for (int it = vcu; it < 512; it += G) { const int bh = it >> 2, e = it & 3, b = bh >> 3, h = bh & 7;
        for (int k = 0; k < 2; ++k) { const int qb = k ? 7 - e : e;
            attn_body::UnitP P; P.Q = QKV_AT(QKV, C_QA + h * 64, 0); P.K = QKV_AT(QKV, C_KA + h * 64, 0); P.V = QKV_AT(QKV, C_VA + h * 64, 0); P.O = QKV_AT(QKV, C_QA + h * 64, 0);
            P.rbase = (long)b * SEQ; P.rstride = 1; P.rsplit = 0; P.vmask = 0x7fffffff; P.vshift = 31;
            P.q0 = qb * 256; P.T0 = 0; P.NT = 4 * qb + 4; P.wqmode = 0; P.km = KML + (size_t)(b * NBLK) * WA + h * 64; P.qb = qb; P.lse = nullptr;
            attn_body::attn_unit<0, 8>(P, shm); } }
}
__device__ __forceinline__ void dil_combine_phase(bf16* QKV, const float* LSE) {
    int t_ = threadIdx.x; asm volatile("" : "+v"(t_)); const int lane = t_ & 63, wave = __builtin_amdgcn_readfirstlane(t_ >> 6);
    const int gw = blockIdx.x * NWAVES + wave, NGW = gridDim.x * NWAVES, slot = lane >> 4;
    for (int m0 = gw * 8; m0 < M; m0 += NGW * 8) {
        float l[8][3]; u32x2 ov[8][3];
#pragma unroll
        for (int q = 0; q < 8; ++q) { const int m = m0 + q; const bf16* p = QKV_AT(QKV, C_QB + slot * 64, m) + (lane & 15) * 4;
#pragma unroll
            for (int g = 0; g < 3; ++g) { l[q][g] = LSE[((size_t)g * M + m) * 4 + slot]; ov[q][g] = *(const u32x2*)(p + (size_t)4 * g * HSLOT); } }
#pragma unroll
        for (int q = 0; q < 8; ++q) { const int m = m0 + q; bf16* p = QKV_AT(QKV, C_QB + slot * 64, m) + (lane & 15) * 4;
            const float mx = fmaxf(l[q][0], fmaxf(l[q][1], l[q][2])); float w0 = __builtin_amdgcn_exp2f(l[q][0] - mx), w1 = __builtin_amdgcn_exp2f(l[q][1] - mx), w2 = __builtin_amdgcn_exp2f(l[q][2] - mx);
            const float inv = 1.f / (w0 + w1 + w2); w0 *= inv; w1 *= inv; w2 *= inv;
            f32x4 o;
#pragma unroll
            for (int i = 0; i < 4; ++i) { const unsigned a = i < 2 ? ov[q][0].x : ov[q][0].y, b = i < 2 ? ov[q][1].x : ov[q][1].y, c = i < 2 ? ov[q][2].x : ov[q][2].y;
                const float fa = (i & 1) ? bf2f(a >> 16) : bf2f(a & 0xffffu), fb = (i & 1) ? bf2f(b >> 16) : bf2f(b & 0xffffu), fc = (i & 1) ? bf2f(c >> 16) : bf2f(c & 0xffffu);
                o[i] = fa * w0 + fb * w1 + fc * w2; }
            st_bf16x4(p, o); }
    }
}
__device__ __forceinline__ void dil_combine_slices(bf16* QKV, const float* LSE, const bool h0, const int pm0, const int s0, const bool h1, const int pm1, const int s1) {
    int t_ = threadIdx.x; asm volatile("" : "+v"(t_));
    u32x4 ov[2][3][4]; float l[2][3][4];
#pragma unroll
    for (int k = 0; k < 2; ++k) { const bool h = k ? h1 : h0; const int pm = k ? pm1 : pm0, sl = k ? s1 : s0;
        if (h) {
#pragma unroll
            for (int j = 0; j < 4; ++j) { const int ci = t_ + NTHREADS * j, row = pm * 256 + (ci >> 3), part = ci & 7;
#pragma unroll
                for (int g = 0; g < 3; ++g) { ov[k][g][j] = *(const u32x4*)(QKV_AT(QKV, C_QB + (4 * g + sl) * 64, row) + part * 8); l[k][g][j] = LSE[((size_t)g * M + row) * 4 + sl]; } } } }
#pragma unroll
    for (int k = 0; k < 2; ++k) { const bool h = k ? h1 : h0; const int pm = k ? pm1 : pm0, sl = k ? s1 : s0;
        if (h) {
#pragma unroll
            for (int j = 0; j < 4; ++j) { const int ci = t_ + NTHREADS * j, row = pm * 256 + (ci >> 3), part = ci & 7;
                const float mx = fmaxf(l[k][0][j], fmaxf(l[k][1][j], l[k][2][j])); float w0 = __builtin_amdgcn_exp2f(l[k][0][j] - mx), w1 = __builtin_amdgcn_exp2f(l[k][1][j] - mx), w2 = __builtin_amdgcn_exp2f(l[k][2][j] - mx);
                const float inv = 1.f / (w0 + w1 + w2); w0 *= inv; w1 *= inv; w2 *= inv;
                f32x4 a0, a1, b0, b1, c0, c1; pg8::unpack8(ov[k][0][j], a0, a1); pg8::unpack8(ov[k][1][j], b0, b1); pg8::unpack8(ov[k][2][j], c0, c1);
                *(u32x4*)(QKV_AT(QKV, C_QB + sl * 64, row) + part * 8) = pg8::pack8(a0 * w0 + b0 * w1 + c0 * w2, a1 * w0 + b1 * w1 + c1 * w2); } } }
}
constexpr int N_PHASES = 27;
struct Args { const float* in[21]; float* out; unsigned char* ws; int ph_lo, ph_hi; };
__global__ void __launch_bounds__(NTHREADS, 2) fwd(Args args) {
    extern __shared__ __attribute__((aligned(16))) unsigned char lds_raw[];
    LAS unsigned char* lds = (LAS unsigned char*)lds_raw;
    volatile LAS unsigned* MISC = (volatile LAS unsigned*)(lds + MISC_OFF);
    const int tid = threadIdx.x, lane = tid & 63, wave = __builtin_amdgcn_readfirstlane(tid >> 6);
    unsigned char* ws = args.ws;
    gu32* ctl = (gu32*)(ws + WS_CTL);
    for (int u = tid; u < (LDS_BYTES - RING_BYTES) / 4; u += NTHREADS) ((LAS unsigned*)(lds + RING_BYTES))[u] = 0u;
    __syncthreads();
    XcdBarrier bar; bar.bar = (unsigned*)(ctl + CW_BAR); bar.x = 0; bar.st = nullptr;
    if (!MK_MULTI) bar = xcd_barrier_post((unsigned*)(ctl + CW_BAR), MISC + 8);
    const int lo = args.ph_lo, hi = args.ph_hi;
#define IN(k) (lo <= (k) && (k) < hi)
#define SEAM(k) do { if (!MK_MULTI && IN((k) + 1)) xcd_barrier(bar); } while (0)

    float* KM = (float*)(ws + WS_KMEAN);
    bf16* H = (bf16*)(ws + WS_H); bf16* QKV = (bf16*)(ws + WS_QKV); bf16* GATES = (bf16*)(ws + WS_GATES); bf16* ACT = (bf16*)(ws + WS_ACT);
    bf16* WSM = (bf16*)(ws + WS_WSM);
    float* X = args.out; float* LSE = (float*)(ws + WS_LSE);
    const int G = gridDim.x, bid = blockIdx.x;

    if (IN(0)) {
        for (int i = bid * NTHREADS + tid; i < 2 * (M / 256) * WA; i += G * NTHREADS) KM[i] = 0.f;
        LAS float* scr = (LAS float*)(lds + wave * 16384);
        const int gw = bid * NWAVES + wave, NGW = G * NWAVES;
        { const int wb = 1;
            convert_job<1>(args.in[wb + 1], D, NIN, (bf16*)((char*)WSM + WSM_IN), D, 0, scr, gw, NGW, lane);
            convert_job<0>(args.in[wb + 2], WA, D, (bf16*)((char*)WSM + WSM_MRG), 768, 0, scr, (gw + NGW - (2944 % NGW)) % NGW, NGW, lane);
            convert_job<0>(args.in[wb + 3], WBO, D, (bf16*)((char*)WSM + WSM_MRG), 768, WA, scr, (gw + NGW - (3200 % NGW)) % NGW, NGW, lane);
            convert_job<0>(args.in[wb + 4], D, D, (bf16*)((char*)WSM + WSM_OUT), D, 0, scr, (gw + NGW - (3328 % NGW)) % NGW, NGW, lane); }
        if (!IN(1)) SEAM(0); else __syncthreads(); }
    for (int L = 0; L < 2; ++L) {
        const int pb = L == 0 ? 1 : 10, wb = L == 0 ? 1 : 10;
        const float* xin = L == 0 ? args.in[0] : X;
        const float* nm = args.in[wb]; const float* nf = args.in[wb + 5];
        float* KML = KM + (size_t)L * (M / 256) * WA;
        const char* Bin = (const char*)WSM + WSM_IN + (size_t)L * NIN * D * 2; const char* Bmrg = (const char*)WSM + WSM_MRG + (size_t)L * D * 768 * 2; const char* Bout = (const char*)WSM + WSM_OUT + (size_t)L * D * D * 2;
        if (IN(pb + 0) && L == 0) { norm_phase<false>(xin, nm, H, nullptr, nullptr, nullptr, nullptr); SEAM(pb + 0); }
        if (IN(pb + 1)) {
            pg8::SchedPlain S; S.o.init(M / 256, NIN / 256, G, bid); S.A = (const char*)H; S.B = Bin; S.lda = D; S.ldb = D; S.ntk = D / 64; S.rowmajor();
            pg8::EpiInProj E{QKV, GATES, KML};
            if (L == 1 && G == 256 && bid >= 128) {
#pragma unroll 1
                for (int i = 0; i < 3; ++i) __builtin_amdgcn_s_sleep(127); }
            pg8::gemm_phase<pg8::EpiInProj, pg8::SchedPlain, true>(lds, S, E);
            if (L == 0) {
                const bool sub = (G == 256);
                if (!sub || bid >= 128) { __syncthreads();
                    int t2_ = threadIdx.x; asm volatile("" : "+v"(t2_)); const int lane = t2_ & 63, wave = __builtin_amdgcn_readfirstlane(t2_ >> 6);
                    LAS float* scr = (LAS float*)(lds + wave * 16384);
                    const int gw = sub ? (bid - 128) * NWAVES + wave : bid * NWAVES + wave, NGW = sub ? 128 * NWAVES : G * NWAVES;
                    convert_job<1>(args.in[11], D, NIN, (bf16*)((char*)WSM + WSM_IN) + (size_t)NIN * D, D, 0, scr, gw, NGW, lane);
                    convert_job<0>(args.in[12], WA, D, (bf16*)((char*)WSM + WSM_MRG) + (size_t)D * 768, 768, 0, scr, (gw + NGW - (2944 % NGW)) % NGW, NGW, lane);
                    convert_job<0>(args.in[13], WBO, D, (bf16*)((char*)WSM + WSM_MRG) + (size_t)D * 768, 768, WA, scr, (gw + NGW - (3200 % NGW)) % NGW, NGW, lane);
                    convert_job<0>(args.in[14], D, D, (bf16*)((char*)WSM + WSM_OUT) + (size_t)D * D, D, 0, scr, (gw + NGW - (3328 % NGW)) % NGW, NGW, lane);
                    convert_job<2>(args.in[7], D, FF0, (bf16*)((char*)WSM + WSM_GU0), D, 0, scr, (gw + NGW - (3840 % NGW)) % NGW, NGW, lane, false, 1.4426950408889634f);
                    convert_job<3>(args.in[8], D, FF0, (bf16*)((char*)WSM + WSM_GU0), D, 0, scr, (gw + NGW - (5248 % NGW)) % NGW, NGW, lane, false, 0.6931471805599453f);
                    convert_job<0>(args.in[9], FF0, D, (bf16*)((char*)WSM + WSM_DN0), FF0, 0, scr, (gw + NGW - (6656 % NGW)) % NGW, NGW, lane, true); } }
            SEAM(pb + 1); }
        if (IN(pb + 2)) {
            attn_phase<true, true>((char*)lds_raw, QKV, KML, LSE);
            SEAM(pb + 2); }
        if (IN(pb + 4)) {
            pg8::SchedMerge S; S.o.init(M / 256, D / 256, G, bid); S.A1 = (const char*)QKV_AT(QKV, C_QA, 0); S.A2 = (const char*)QKV_AT(QKV, C_QB, 0); S.B = Bmrg; S.lda = 64; S.ldb = 768;
            pg8::EpiMerge2 E{GATES, H};
            {
                gu32* ccnt = ctl + CW_CMB + L * 256;
                pg8::Unit u0, u1; const bool h0 = S.next(0, u0), h1 = S.next(2, u1);
                dil_combine_slices(QKV, LSE, h0, u0.pm, u0.pn, h1, u1.pm, u1.pn);
                asm volatile("s_waitcnt vmcnt(0)" ::: "memory");
                __syncthreads();
                if (threadIdx.x == 0) {
                    __builtin_amdgcn_fence(__ATOMIC_RELEASE, "agent");
                    if (h0) __hip_atomic_fetch_add(ccnt + 2 * u0.pm, 1u, RLX_AGENT);
                    if (h1) __hip_atomic_fetch_add(ccnt + 2 * u1.pm, 1u, RLX_AGENT);
                    unsigned sp = 0;
                    while ((h0 && __hip_atomic_load(ccnt + 2 * u0.pm, RLX_AGENT) < 4u) || (h1 && __hip_atomic_load(ccnt + 2 * u1.pm, RLX_AGENT) < 4u)) { __builtin_amdgcn_s_sleep(2); if (++sp > (1u << 22)) break; }
                    __builtin_amdgcn_fence(__ATOMIC_ACQUIRE, "agent"); }
                __syncthreads(); }
            pg8::gemm_phase<pg8::EpiMerge2, pg8::SchedMerge, true>(lds, S, E);
            SEAM(pb + 4); }
        if (IN(pb + 5)) {
            pg8::SchedPlain S; S.o.init(M / 256, D / 256, G, bid); S.A = (const char*)H; S.B = Bout; S.lda = D; S.ldb = D; S.ntk = D / 64; S.rowmajor();
            if (L == 0) { pg8::EpiResNorm E{xin, X, nf, H, (float*)(ws + WS_XCH), ctl + CW_PCNT, lds + RING_BYTES + 2048};
                          pg8::gemm_phase<pg8::EpiResNorm, pg8::SchedPlain, true>(lds, S, E); }
            else { pg8::EpiRes2 E{xin, X};
                   pg8::gemm_phase<pg8::EpiRes2, pg8::SchedPlain, true>(lds, S, E); }
            SEAM(pb + 5); }
        if (L == 0) {
            if (IN(pb + 7)) {
                pg8::SchedPlain S; S.o.init(M / 256, 2 * FF0 / 256, G, bid); S.A = (const char*)H; S.B = (const char*)WSM + WSM_GU0; S.lda = D; S.ldb = D; S.ntk = D / 64; S.rowmajor();
                pg8::EpiSwiglu2 E{ACT, FF0};
                pg8::gemm_phase<pg8::EpiSwiglu2, pg8::SchedPlain, true>(lds, S, E);
                SEAM(pb + 7); }
            if (IN(pb + 8)) {
                pg8::SchedPlain S; S.o.init(M / 256, D / 256, G, bid); S.A = (const char*)ACT; S.B = (const char*)WSM + WSM_DN0; S.ntk = FF0 / 64; S.tiled();
                pg8::EpiResNorm E{X, X, args.in[10], H, (float*)(ws + WS_XCH) + (size_t)M * 4, ctl + CW_PCNT + 128 * 16, lds + RING_BYTES + 2048};
                pg8::gemm_phase<pg8::EpiResNorm, pg8::SchedPlain, true>(lds, S, E);
                SEAM(pb + 8); }
        } else {
            int* tokrow = (int*)(ws + WS_TOK); float* wrow = (float*)(tokrow + 2 * MOE_LROWS); int* tk_e = (int*)(wrow + 2 * MOE_LROWS); float* tk_w = (float*)(tk_e + M); int* tokposA = (int*)(ws + WS_TOK + MiB);
            bf16* Hs = (bf16*)(ws + WS_HS); bf16* ACT1 = (bf16*)(ws + WS_ACT1); const char* EXPW = (const char*)(ws + WS_EXPW);
            if (IN(pb + 6)) { moe_router_phase(lds, X, nf, H, args.in[16], args.in[17], args.in[18], args.in[19], tk_e, tk_w, tokrow, ws, ctl); SEAM(pb + 6); }
            if (IN(pb + 7)) { moe_dispatch_phase(lds, H, Hs, tk_e, tk_w, tokrow, wrow, ctl, tokposA); SEAM(pb + 7); }
            bf16* ACTr = (bf16*)(ws + WS_WSM);
            int tsA[9], tsB[9]; tsA[0] = 0; tsB[0] = 0;
            {
#pragma unroll
                for (int e = 0; e < NEXP; ++e) { tsA[e + 1] = tsA[e] + (int)((__hip_atomic_load(ctl + CW_CNT + e, RLX_AGENT) + 255u) >> 8); tsB[e + 1] = tsB[e] + (int)((__hip_atomic_load(ctl + CW_CNT + 8 + e, RLX_AGENT) + 255u) >> 8); }
#pragma unroll
                for (int e = 1; e <= NEXP; ++e) { tsA[e] = __builtin_amdgcn_readfirstlane(tsA[e]); tsB[e] = __builtin_amdgcn_readfirstlane(tsB[e]); } }
            for (int j = 0; j < 12; ++j) {
                const int code = j == 0 ? (0 | 0 << 1 | 2 << 2 | 0 << 5) : j == 1 ? (0 | 1 << 1 | 2 << 2 | 0 << 5) : j == 2 ? (0 | 0 << 1 | 0 << 2 | 0 << 5) : j == 3 ? (1 | 0 << 1 | 0 << 2 | 1 << 5)
                               : j == 4 ? (1 | 0 << 1 | 2 << 2 | 2 << 5) : j == 5 ? (0 | 0 << 1 | 1 << 2 | 1 << 4 | 2 << 5) : j == 6 ? (1 | 0 << 1 | 1 << 2 | 3 << 5) : j == 7 ? (1 | 1 << 1 | 2 << 2 | 4 << 5)
                               : j == 8 ? (0 | 1 << 1 | 0 << 2 | 1 << 4 | 4 << 5) : j == 9 ? (1 | 1 << 1 | 0 << 2 | 5 << 5) : j == 10 ? (0 | 1 << 1 | 1 << 2 | 6 << 5) : (1 | 1 << 1 | 1 << 2 | 7 << 5);
                const int type = code & 1, l = (code >> 1) & 1, c = (code >> 2) & 3, skew = (code >> 4) & 1, ph = code >> 5;
                const bool last_of_phase = (j == 2 || j == 3 || j == 5 || j == 6 || j == 8 || j == 9 || j == 10 || j == 11);
                if (!IN(pb + 8 + ph)) continue;
                int ts[9]; ts[0] = 0;
#pragma unroll
                for (int e = 1; e <= NEXP; ++e) ts[e] = l ? tsB[e] : tsA[e];
                const int rt0 = MOE_CH_TILES * c, cap = c < 2 ? MOE_CH_TILES : 8, nrt = ts[8] - rt0 < 0 ? 0 : (ts[8] - rt0 > cap ? cap : ts[8] - rt0);
                const int nrem = ts[8] - 2 * MOE_CH_TILES < 0 ? 0 : ts[8] - 2 * MOE_CH_TILES;
                bf16* ACTb = c < 2 ? ACT1 : ACTr + (size_t)l * 8 * 256 * FFE;
                pg8::SchedMoe S; S.rt0 = rt0; S.ts1 = ts[1]; S.ts2 = ts[2]; S.ts3 = ts[3]; S.ts4 = ts[4]; S.ts5 = ts[5]; S.ts6 = ts[6]; S.ts7 = ts[7];
                if (type == 0) {
                    int cdeal = bid;
                    if (j == 1) { const int tA = tsA[8];
                        const int nremA = tA - 2 * MOE_CH_TILES < 0 ? 0 : (tA - 2 * MOE_CH_TILES > 8 ? 8 : tA - 2 * MOE_CH_TILES);
                        const int off = ((2 * FFE / 256) * nremA + 7) & ~7; cdeal = (bid + G - (off % G)) % G; }
                    S.o.init(nrt, 2 * FFE / 256, G, cdeal); if (skew) { S.o.nskip = 4 * nrem; S.o.iskip = 6; }
                    S.A = (const char*)(Hs + (size_t)l * MOE_LROWS * D); S.B = EXPW; S.lda = D; S.ldb = D; S.ntk = D / 64; S.rowmajor(); S.estride = (size_t)2 * FFE * D * 2; S.a_chunk_local = false;
                    pg8::EpiSwiglu2 E{ACTb, FFE};
                    pg8::gemm_phase<pg8::EpiSwiglu2, pg8::SchedMoe, true>(lds, S, E);
                } else {
                    S.o.init(nrt, D / 256, G, bid); S.A = (const char*)ACTb; S.B = EXPW + EXPW_DN; S.ntk = FFE / 64; S.tiled(); S.estride = (size_t)D * FFE * 2; S.a_chunk_local = true;
                    if (l == 0) { pg8::EpiMoeDownA E{Hs, wrow};
                                  pg8::gemm_phase<pg8::EpiMoeDownA, pg8::SchedMoe, true>(lds, S, E); }
                    else { pg8::EpiMoeDownNorm E{X, tokrow + (size_t)MOE_LROWS, wrow + (size_t)MOE_LROWS, args.in[20], (float*)(ws + WS_XCH), ctl + CW_PCNT + 2 * 128 * 16, lds + RING_BYTES + 2048, Hs, tokposA};
                           pg8::gemm_phase<pg8::EpiMoeDownNorm, pg8::SchedMoe, true>(lds, S, E); }
                }
                if (last_of_phase && j != 11) SEAM(pb + 8 + ph); else __syncthreads();
            }
        }
    }

#undef IN
#undef SEAM
}

extern "C" void kernel_launch(void* const* d_in, const int* in_sizes, int n_in, void* d_out, int out_size, void* d_ws, size_t ws_size, hipStream_t stream) {
    static int grid = 0;
    if (grid == 0) {
        if (n_in != 21 || out_size != M * D || ws_size < WS_END) { fprintf(stderr, "kernel_launch: unexpected problem (n_in %d out %d ws %zu, need %zu)\n", n_in, out_size, ws_size, (size_t)WS_END); grid = -1; return; }
        int dev = 0, cus = 0, per_cu = 0;
        if (hipGetDevice(&dev) != hipSuccess || hipDeviceGetAttribute(&cus, hipDeviceAttributeMultiprocessorCount, dev) != hipSuccess) { grid = -1; return; }
        if (hipFuncSetAttribute((const void*)fwd, hipFuncAttributeMaxDynamicSharedMemorySize, LDS_BYTES) != hipSuccess) { fprintf(stderr, "kernel_launch: hipFuncSetAttribute failed\n"); grid = -1; return; }
        if (hipOccupancyMaxActiveBlocksPerMultiprocessor(&per_cu, (const void*)fwd, NTHREADS, LDS_BYTES) != hipSuccess || per_cu < 1) fprintf(stderr, "kernel_launch: occupancy query says %d\n", per_cu);
        (void)hipGetLastError();
        grid = cus;
    }
    if (grid < 0) return;
    (void)hipMemsetAsync((char*)d_ws + WS_CTL, 0, CTL_ZERO_BYTES, stream);
    Args a{};
    for (int i = 0; i < 21; ++i) a.in[i] = (const float*)d_in[i];
    a.out = (float*)d_out; a.ws = (unsigned char*)d_ws;
#if MK_MULTI
    for (int p = 0; p < N_PHASES; ++p) { a.ph_lo = p; a.ph_hi = p + 1; hipLaunchKernelGGL(fwd, dim3(grid), dim3(NTHREADS), LDS_BYTES, stream, a); }
#else
    a.ph_lo = 0; a.ph_hi = N_PHASES; hipLaunchKernelGGL(fwd, dim3(grid), dim3(NTHREADS), LDS_BYTES, stream, a);
#endif
}
```

```cpp
#include <hip/hip_runtime.h>
#include <cstdio>
#include <cstdint>
#include <cmath>

#ifndef MK_MULTI
#define MK_MULTI 0
#endif

#define GAS __attribute__((address_space(1)))
#define LAS __attribute__((address_space(3)))
typedef unsigned short bf16;
typedef float f32x4 __attribute__((ext_vector_type(4)));
typedef float f32x2 __attribute__((ext_vector_type(2)));
typedef unsigned u32x4 __attribute__((ext_vector_type(4)));
typedef unsigned u32x2 __attribute__((ext_vector_type(2)));
typedef GAS unsigned gu32;
#define RLX_AGENT __ATOMIC_RELAXED, __HIP_MEMORY_SCOPE_AGENT

constexpr int BATCH = 16, SEQ = 2048, D = 1024, M = BATCH * SEQ;
constexpr int HD = 64, MOBA_H = 8, MOBA_BLK = 256, NBLK = SEQ / MOBA_BLK, MOBA_TOPK = 3;
constexpr int WA = 512, WB = 768, WBO = 256;
constexpr int NQKV = 3 * WA + 3 * WB;
constexpr int NIN = NQKV + 2 * D;
constexpr int C_QA = 0, C_KA = 512, C_VA = 1024, C_QB = 1536, C_KB = 2304, C_VB = 3072;
constexpr size_t HSLOT = (size_t)M * 64;
#define QKV_AT(base, col, row) ((base) + (size_t)((col) >> 6) * HSLOT + (size_t)(row) * 64 + ((col) & 63))
constexpr int FF0 = 2816, NEXP = 8, FFE = 3584;
constexpr float RMS_EPS = 1e-6f;
constexpr int NWAVES = 8, NTHREADS = 512;

constexpr size_t MiB = 1u << 20;
constexpr size_t WS_CTL = 0, CTL_ZERO_BYTES = 64 * 1024;
constexpr size_t WS_ROPE = 1 * MiB;
constexpr size_t WS_KMEAN = WS_ROPE + 512 * 1024;
constexpr size_t WS_COMB = 2 * MiB;
constexpr size_t WS_WSM = 4 * MiB;
constexpr size_t WSM_IN = 0, WSM_MRG = 2 * (size_t)NIN * D * 2, WSM_OUT = WSM_MRG + 2 * (size_t)D * 768 * 2, WSM_GU0 = WSM_OUT + 2 * (size_t)D * D * 2,
                 WSM_DN0 = WSM_GU0 + (size_t)2 * FF0 * D * 2, WSM_END = WSM_DN0 + (size_t)D * FF0 * 2;
static_assert(WSM_END <= 48 * MiB, "weight copies");
constexpr size_t WS_H = 52 * MiB;
constexpr size_t WS_BIG = 116 * MiB;
constexpr size_t WS_QKV = WS_BIG;
constexpr size_t WS_GATES = WS_QKV + (size_t)M * NQKV * 2;
constexpr size_t WS_ACT = WS_BIG;
constexpr size_t WS_END0 = WS_GATES + (size_t)M * 2 * D * 2;
constexpr int MOE_LROWS = M + NEXP * 256;
constexpr int MOE_CH_TILES = 64;
constexpr size_t WS_EXPW = WS_BIG;
constexpr size_t EXPW_DN = (size_t)NEXP * 2 * FFE * D * 2;
constexpr size_t WS_HS = WS_EXPW + (size_t)NEXP * 3 * FFE * D * 2;
constexpr size_t WS_ACT1 = WS_HS + (size_t)2 * MOE_LROWS * D * 2;
constexpr size_t WS_END1 = WS_ACT1 + (size_t)MOE_CH_TILES * 256 * FFE * 2;
constexpr size_t WS_END = WS_END0 > WS_END1 ? WS_END0 : WS_END1;
constexpr size_t WS_LSE = 2 * MiB;
constexpr size_t WS_TOK = 2 * MiB;
constexpr int CW_CNT = 8192, CW_FILL = 8192 + 64;
constexpr int CW_BAR = 4096;
constexpr int CW_PCNT = 9216;
constexpr size_t WS_XCH = 128 * 1024;

__device__ __forceinline__ float bf2f(unsigned b) { return __uint_as_float(b << 16); }
__device__ __forceinline__ unsigned f2bf(float f) { unsigned u = __float_as_uint(f); return (u + 0x7fffu + ((u >> 16) & 1u)) >> 16; }
__device__ __forceinline__ unsigned pk2(float lo, float hi) { return f2bf(lo) | (f2bf(hi) << 16); }
template <int O> __device__ __forceinline__ float xor_lane(float v) { return __int_as_float(__builtin_amdgcn_ds_swizzle(__float_as_int(v), (O << 10) | 0x1f)); }
__device__ __forceinline__ float wave_sum(float v) {
    v += xor_lane<1>(v); v += xor_lane<2>(v); v += xor_lane<4>(v); v += xor_lane<8>(v); v += xor_lane<16>(v);
    { auto rr = __builtin_amdgcn_permlane32_swap(__float_as_uint(v), __float_as_uint(v), false, false); v = __uint_as_float(rr[0]) + __uint_as_float(rr[1]); }
    return v;
}
__device__ __forceinline__ float wave_max(float v) {
    v = fmaxf(v, xor_lane<1>(v)); v = fmaxf(v, xor_lane<2>(v)); v = fmaxf(v, xor_lane<4>(v)); v = fmaxf(v, xor_lane<8>(v)); v = fmaxf(v, xor_lane<16>(v));
    { auto rr = __builtin_amdgcn_permlane32_swap(__float_as_uint(v), __float_as_uint(v), false, false); v = fmaxf(__uint_as_float(rr[0]), __uint_as_float(rr[1])); }
    return v;
}

#define XB_TMO      128
#define XB_XCNT(j)  (256  + 64 * (j))
#define XB_XSUB(j)  (1280 + 64 * (j))
#define XB_XGEN(j)  (2304 + 64 * (j))
#define XB_TOP      3328
#define XB_TOPGEN   3392
#define XCD_BAR_WORDS 3456
#define XB_SPIN_CAP (1u << 22)

__device__ __forceinline__ unsigned xb_ld(unsigned* p)              { return __hip_atomic_load(p, __ATOMIC_RELAXED, __HIP_MEMORY_SCOPE_AGENT); }
__device__ __forceinline__ unsigned xb_add(unsigned* p, unsigned v) { return __hip_atomic_fetch_add(p, v, __ATOMIC_RELAXED, __HIP_MEMORY_SCOPE_AGENT); }
__device__ __forceinline__ unsigned xb_xcc_id() { return (unsigned)__builtin_amdgcn_s_getreg((3 << 11) | 20) & 0xFu; }
#define XB_SPIN(cond, bar) do { unsigned _sp = 0; while (cond) { __builtin_amdgcn_s_sleep(1); \
    if ((++_sp & 255u) == 0u) { if (xb_ld(&(bar)[XB_TMO])) break; if (_sp > XB_SPIN_CAP) { atomicAdd(&(bar)[XB_TMO], 1u); break; } } } } while (0)

struct XcdBarrier { unsigned* bar; unsigned x; volatile LAS unsigned* st; int w = -1; };
__device__ __forceinline__ int lane_now() { int l; asm volatile("v_mbcnt_lo_u32_b32 %0, -1, 0\n\tv_mbcnt_hi_u32_b32 %0, -1, %0" : "=v"(l)); return l; }

__device__ __forceinline__ XcdBarrier xcd_barrier_post(unsigned* bar, volatile LAS unsigned* st) {
    XcdBarrier b; b.bar = bar; b.x = xb_xcc_id(); b.st = st;
    if (threadIdx.x == 0) (void)xb_add(&bar[XB_XCNT(b.x)], 1u);
    return b;
}
__device__ __forceinline__ void xcd_barrier_complete(unsigned* bar, unsigned x, unsigned& nloc, unsigned& nx) {
    const unsigned G = gridDim.x * gridDim.y * gridDim.z;
    unsigned sum, cnt, mine, sp = 0u;
    for (;;) {
        sum = 0u; cnt = 0u; mine = 0u;
#pragma unroll
        for (unsigned j = 0; j < 16; ++j) { const unsigned c = xb_ld(&bar[XB_XCNT(j)]); sum += c; cnt += (c > 0u) ? 1u : 0u; mine = (j == x) ? c : mine; }
        if (sum == G) break;
        __builtin_amdgcn_s_sleep(1);
        if ((++sp & 255u) == 0u) { if (xb_ld(&bar[XB_TMO])) break; if (sp > XB_SPIN_CAP) { atomicAdd(&bar[XB_TMO], 1u); break; } }
    }
    nloc = mine > 0u ? mine : 1u; nx = cnt > 0u ? cnt : 1u;
}
__device__ __forceinline__ void xcd_barrier(const XcdBarrier& b) {
    asm volatile("s_waitcnt vmcnt(0)" ::: "memory");
    __syncthreads();
    if (b.w >= 0 ? (b.w == 0 && lane_now() == 0) : threadIdx.x == 0) {
        unsigned* bar = b.bar;
        __builtin_amdgcn_s_waitcnt(0);
        unsigned nloc = b.st[0], nx = b.st[1];
        if (nloc == 0u) { xcd_barrier_complete(bar, b.x, nloc, nx); b.st[0] = nloc; b.st[1] = nx; }
        const unsigned old = xb_add(&bar[XB_XSUB(b.x)], 1u);
        const unsigned gen = old / nloc;
        if (old + 1u == (gen + 1u) * nloc) {
            __builtin_amdgcn_fence(__ATOMIC_RELEASE, "agent");
            asm volatile("s_waitcnt vmcnt(0)" ::: "memory");
            const unsigned og = xb_add(&bar[XB_TOP], 1u);
            const unsigned tg = og / nx;
            if (og + 1u == (tg + 1u) * nx) xb_add(&bar[XB_TOPGEN], 1u);
            else XB_SPIN(xb_ld(&bar[XB_TOPGEN]) == tg, bar);
            __builtin_amdgcn_fence(__ATOMIC_ACQUIRE, "agent");
            xb_add(&bar[XB_XGEN(b.x)], 1u);
            asm volatile("s_waitcnt vmcnt(0)" ::: "memory");
        } else {
            XB_SPIN(xb_ld(&bar[XB_XGEN(b.x)]) == gen, bar);
            __builtin_amdgcn_fence(__ATOMIC_ACQUIRE, "agent");
            asm volatile("s_waitcnt vmcnt(0)" ::: "memory");
        }
    }
    __syncthreads();
}

constexpr int RING_BYTES = 131072, LDS_BYTES = 147456, MISC_OFF = LDS_BYTES - 256;

__device__ __forceinline__ void st_bf16x4(bf16* p, f32x4 v) { u32x2 w; w.x = pk2(v[0], v[1]); w.y = pk2(v[2], v[3]); *(u32x2*)p = w; }

namespace pg8 {
typedef short bf16x8 __attribute__((ext_vector_type(8)));
constexpr int BM = 256, BK = 64, HALF = 128, HTB = HALF * BK * 2, STAGE_BYTES = 8 * HTB, NXCD = 8, WGM = 4;
__host__ __device__ __forceinline__ int lds_byte(int r, int c) { const int st = (r >> 4) * 2 + (c >> 5), rr = r & 15, cc = c & 31, ob = rr * 64 + cc * 2; return st * 1024 + (ob ^ (((ob >> 9) & 1) << 5)); }
__host__ __device__ __forceinline__ void stage_rc(int b, int& R, int& C) { const int st = b / 1024, sb = b % 1024, swz = sb ^ (((sb >> 9) & 1) << 5); R = (st >> 1) * 16 + swz / 64; C = (st & 1) * 32 + (swz % 64) / 2; }
__host__ __device__ __forceinline__ int perm32(int rho) { const int n = rho >> 4, i = rho & 15; return 8 * (i >> 2) + 4 * n + (i & 3); }
struct Unit { int pm, pn, sub, aux; };
struct TileOrder {
    int nM, nN, nwg, G, c, nskip = 0, iskip = 0;
    __device__ __forceinline__ void init(int nM_, int nN_, int G_, int c_) { nM = nM_; nN = nN_; nwg = nM * nN; G = G_; c = c_; nskip = 0; iskip = 0; }
    __device__ __forceinline__ bool tile(int i, int& pm, int& pn) const {
        const long L = c < nskip ? (long)iskip * (G - nskip) + (long)i * G + c
                                 : (i < iskip ? (long)i * (G - nskip) + (c - nskip) : (long)iskip * (G - nskip) + (long)(i - iskip) * G + c);
        if (L >= nwg) return false;
        int wgid = (int)L; { const int q = nwg / NXCD, r = nwg % NXCD, xcd = wgid % NXCD, off = wgid / NXCD; wgid = (xcd < r ? xcd * (q + 1) : r * (q + 1) + (xcd - r) * q) + off; }
        const int nig = WGM * nN, gid = wgid / nig, fm = gid * WGM, gsz = (nM - fm) < WGM ? (nM - fm) : WGM;
        pm = fm + ((wgid % nig) % gsz); pn = (wgid % nig) / gsz; return true;
    }
};
constexpr size_t KT_BYTES = (size_t)BM * BK * 2;
struct SchedPlain {
    TileOrder o; const char* A; const char* B; int lda, ldb, ntk; size_t kA = BK * 2, kB = BK * 2, atile = 0, btile = 0;
    __device__ __forceinline__ void rowmajor() { kA = kB = BK * 2; atile = (size_t)BM * lda * 2; btile = (size_t)BM * ldb * 2; }
    __device__ __forceinline__ void tiled() { lda = ldb = BK; kA = kB = KT_BYTES; atile = btile = (size_t)ntk * KT_BYTES; }
    __device__ __forceinline__ bool next(int i, Unit& u) const { u.sub = 0; u.aux = 0; return o.tile(i, u.pm, u.pn); }
    __device__ __forceinline__ const char* aptr(const Unit& u) const { return A + (size_t)u.pm * atile; }
    __device__ __forceinline__ const char* bptr(const Unit& u) const { return B + (size_t)u.pn * btile; }
    __device__ __forceinline__ int nt(const Unit&) const { return ntk; }
};
struct SchedMerge {
    static constexpr size_t kA = HSLOT * 2, kB = BK * 2;
    TileOrder o; const char* A1; const char* A2; const char* B; int lda, ldb;
    __device__ __forceinline__ bool next(int i, Unit& u) const { u.sub = i & 1; u.aux = 0; return o.tile(i >> 1, u.pm, u.pn); }
    __device__ __forceinline__ const char* aptr(const Unit& u) const { return (u.sub ? A2 : A1) + (size_t)u.pm * BM * lda * 2; }
    __device__ __forceinline__ const char* bptr(const Unit& u) const { return B + (size_t)u.pn * BM * ldb * 2 + (u.sub ? WA * 2 : 0); }
    __device__ __forceinline__ int nt(const Unit& u) const { return u.sub ? WBO / BK : WA / BK; }
};

typedef __bf16 bf16x2_t __attribute__((ext_vector_type(2)));
__device__ __forceinline__ unsigned cvt_pk_bf16(float lo, float hi) { const f32x2 v = {lo, hi}; const bf16x2_t b = __builtin_convertvector(v, bf16x2_t); return __builtin_bit_cast(unsigned, b); }
__device__ __forceinline__ u32x4 pack8(f32x4 a, f32x4 b) { u32x4 w; w.x = cvt_pk_bf16(a[0], a[1]); w.y = cvt_pk_bf16(a[2], a[3]); w.z = cvt_pk_bf16(b[0], b[1]); w.w = cvt_pk_bf16(b[2], b[3]); return w; }
__device__ __forceinline__ void unpack8(u32x4 w, f32x4& a, f32x4& b) {
    a = (f32x4){__uint_as_float(w.x << 16), __uint_as_float(w.x & 0xffff0000u), __uint_as_float(w.y << 16), __uint_as_float(w.y & 0xffff0000u)};
    b = (f32x4){__uint_as_float(w.z << 16), __uint_as_float(w.z & 0xffff0000u), __uint_as_float(w.w << 16), __uint_as_float(w.w & 0xffff0000u)}; }
__device__ __forceinline__ f32x4 isig4(f32x4 v) { f32x4 o;
#pragma unroll
    for (int i = 0; i < 4; ++i) o[i] = fminf(1.f + __builtin_amdgcn_exp2f(-v[i]), 1e18f); return o; }
__device__ __forceinline__ f32x4 sig4(f32x4 v) { f32x4 o;
#pragma unroll
    for (int i = 0; i < 4; ++i) o[i] = __builtin_amdgcn_rcpf(1.f + __builtin_amdgcn_exp2f(-v[i])); return o; }

struct EpiInProj {
    static constexpr bool PERM = true;
    static constexpr int SLACK = 0;
    bf16* QKV; bf16* GATES; float* KM;
    __device__ __forceinline__ bool keep(const Unit&) const { return false; }
    __device__ __forceinline__ void operator()(f32x4 (&acc)[2][2][4][2], const Unit& u, int wr, int wc, int fr, int fq) const {
        const int row0 = u.pm * BM + wr * 64 + fr, pn = u.pn;
        if (pn < 15) {
            const bool rope = !(pn == 4 || pn == 5 || pn >= 12), km = (pn == 2 || pn == 3);
            const int colL = pn * BM + 64 * wc + 8 * fq;
            float fi[8];
#pragma unroll
            for (int j = 0; j < 8; ++j) fi[j] = __builtin_amdgcn_exp2f(-(float)(8 * fq + j) * (13.287712379549449f / 32.0f)) * 0.15915494309189535f;
            f32x4 cs[4] = {(f32x4){0.f, 0.f, 0.f, 0.f}, (f32x4){0.f, 0.f, 0.f, 0.f}, (f32x4){0.f, 0.f, 0.f, 0.f}, (f32x4){0.f, 0.f, 0.f, 0.f}};
#pragma unroll
            for (int ai = 0; ai < 2; ++ai)
#pragma unroll
                for (int m = 0; m < 4; ++m) {
                    const int row = row0 + ai * HALF + m * 16;
                    f32x4 a0 = acc[ai][0][m][0], a1 = acc[ai][0][m][1], b0 = acc[ai][1][m][0], b1 = acc[ai][1][m][1];
                    if (rope) { const float pos = (float)(row & (SEQ - 1)); f32x4 c0, c1, s0, s1;
#pragma unroll
                        for (int j = 0; j < 4; ++j) { const float r0 = __builtin_amdgcn_fractf(pos * fi[j]), r1 = __builtin_amdgcn_fractf(pos * fi[4 + j]);
                            c0[j] = __builtin_amdgcn_cosf(r0); s0[j] = __builtin_amdgcn_sinf(r0); c1[j] = __builtin_amdgcn_cosf(r1); s1[j] = __builtin_amdgcn_sinf(r1); }
                        const f32x4 y0 = a0 * c0 - b0 * s0, y1 = a1 * c1 - b1 * s1, z0 = b0 * c0 + a0 * s0, z1 = b1 * c1 + a1 * s1;
                        a0 = y0; a1 = y1; b0 = z0; b1 = z1; }
                    if (pn < 2 || (pn >= 6 && pn < 9)) { const float c2 = 0.125f * 1.4426950408889634f; a0 *= c2; a1 *= c2; b0 *= c2; b1 *= c2; }
                    if (km) { cs[0] += a0; cs[1] += a1; cs[2] += b0; cs[3] += b1; }
                    bf16* p = QKV_AT(QKV, colL, row);
                    *(u32x4*)p = pack8(a0, a1); *(u32x4*)(p + 32) = pack8(b0, b1);
                }
            if (km) {
#pragma unroll
                for (int q = 0; q < 4; ++q)
#pragma unroll
                    for (int j = 0; j < 4; ++j) { float v = cs[q][j]; v += xor_lane<1>(v); v += xor_lane<2>(v); v += xor_lane<4>(v); v += xor_lane<8>(v); cs[q][j] = v; }
                if (fr == 0) { float* kp = KM + (size_t)u.pm * WA + (pn - 2) * BM + 64 * wc + 8 * fq;
#pragma unroll
                    for (int q = 0; q < 4; ++q)
#pragma unroll
                        for (int j = 0; j < 4; ++j) atomicAdd(kp + (q >> 1) * 32 + (q & 1) * 4 + j, cs[q][j] * (1.f / 256.f)); }
            }
        } else {
            const int col = (pn - 15) * BM + 32 * wc + 8 * fq;
#pragma unroll
            for (int ai = 0; ai < 2; ++ai)
#pragma unroll
                for (int m = 0; m < 4; ++m) { bf16* p = GATES + (size_t)(row0 + ai * HALF + m * 16) * (2 * D) + col;
#pragma unroll
                    for (int bj = 0; bj < 2; ++bj) *(u32x4*)(p + bj * HALF) = pack8(isig4(acc[ai][bj][m][0]), isig4(acc[ai][bj][m][1])); }
        }
    }
};
struct EpiSwiglu2 {
    static constexpr bool PERM = true;
    static constexpr int SLACK = 8;
    bf16* O; int ldo;
    __device__ __forceinline__ bool keep(const Unit&) const { return false; }
    __device__ __forceinline__ void operator()(f32x4 (&acc)[2][2][4][2], const Unit& u, int wr, int wc, int fr, int fq) const {
        const int r0 = wr * 64 + fr, col = u.pn * HALF + 32 * wc + 8 * fq;
        bf16* base = O + ((size_t)u.pm * (ldo >> 6) + (col >> 6)) * (BM * BK) + (col & 63);
#pragma unroll
        for (int ai = 0; ai < 2; ++ai)
#pragma unroll
            for (int m = 0; m < 4; ++m) { const f32x4 g0 = acc[ai][0][m][0], g1 = acc[ai][0][m][1];
                *(u32x4*)(base + (r0 + ai * HALF + m * 16) * BK) = pack8(g0 * sig4(g0) * acc[ai][1][m][0], g1 * sig4(g1) * acc[ai][1][m][1]); }
    }
};
struct EpiRes2 {
    static constexpr bool PERM = false;
    static constexpr int SLACK = 16;
    const float* xin; float* xout;
    __device__ __forceinline__ bool keep(const Unit&) const { return false; }
    __device__ __forceinline__ void operator()(f32x4 (&acc)[2][2][4][2], const Unit& u, int wr, int wc, int fr, int fq) const {
        const int row0 = u.pm * BM + wr * 64 + fr, col0 = u.pn * BM + wc * 32 + 4 * fq;
#pragma unroll
        for (int ai = 0; ai < 2; ++ai) { f32x4 b[4][2][2];
#pragma unroll
            for (int m = 0; m < 4; ++m) { const size_t off = (size_t)(row0 + ai * HALF + m * 16) * D + col0;
#pragma unroll
                for (int bj = 0; bj < 2; ++bj)
#pragma unroll
                    for (int n = 0; n < 2; ++n) b[m][bj][n] = *(const f32x4*)(xin + off + bj * HALF + n * 16); }
#pragma unroll
            for (int m = 0; m < 4; ++m) { const size_t off = (size_t)(row0 + ai * HALF + m * 16) * D + col0;
#pragma unroll
                for (int bj = 0; bj < 2; ++bj)
#pragma unroll
                    for (int n = 0; n < 2; ++n) *(f32x4*)(xout + off + bj * HALF + n * 16) = b[m][bj][n] + acc[ai][bj][m][n]; } }
    }
};
struct EpiResNorm {
    static constexpr bool PERM = true;
    static constexpr int SLACK = 16;
    const float* xin; float* xout; const float* g; bf16* H; float* xch; gu32* cnt; LAS unsigned char* tab;
    __device__ __forceinline__ bool keep(const Unit&) const { return false; }
    __device__ __forceinline__ void operator()(f32x4 (&acc)[2][2][4][2], const Unit& u, int wr, int wc, int fr, int fq) const {
        const int wid = wr * 4 + wc, lane = fr + 16 * fq;
        const int row0 = u.pm * BM + wr * 64 + fr, col0 = u.pn * BM + 32 * wc + 8 * fq;
        LAS float* P = (LAS float*)tab; LAS float* S = P + 1024; LAS unsigned* flag = (LAS unsigned*)(S + 256);
#pragma unroll
        for (int ai = 0; ai < 2; ++ai) { f32x4 b[4][2][2];
#pragma unroll
            for (int m = 0; m < 4; ++m) { const size_t off = (size_t)(row0 + ai * HALF + m * 16) * D + col0;
#pragma unroll
                for (int bj = 0; bj < 2; ++bj)
#pragma unroll
                    for (int n = 0; n < 2; ++n) b[m][bj][n] = *(const f32x4*)(xin + off + bj * HALF + n * 4); }
#pragma unroll
            for (int m = 0; m < 4; ++m) { const size_t off = (size_t)(row0 + ai * HALF + m * 16) * D + col0; float q = 0.f;
#pragma unroll
                for (int bj = 0; bj < 2; ++bj)
#pragma unroll
                    for (int n = 0; n < 2; ++n) { const f32x4 v = b[m][bj][n] + acc[ai][bj][m][n]; acc[ai][bj][m][n] = v; *(f32x4*)(xout + off + bj * HALF + n * 4) = v; q += (v[0] * v[0] + v[1] * v[1]) + (v[2] * v[2] + v[3] * v[3]); }
                q += xor_lane<16>(q); { auto rr = __builtin_amdgcn_permlane32_swap(__float_as_uint(q), __float_as_uint(q), false, false); q = __uint_as_float(rr[0]) + __uint_as_float(rr[1]); }
                if (fq == 0) P[(ai * HALF + wr * 64 + m * 16 + fr) * 4 + wc] = q; } }
        asm volatile("s_waitcnt lgkmcnt(0)\n\ts_barrier" ::: "memory");
        const int row = wid * 32 + (lane & 31);
        if (lane < 32) { const float t = (P[row * 4 + 0] + P[row * 4 + 1]) + (P[row * 4 + 2] + P[row * 4 + 3]);
            __hip_atomic_store(xch + ((size_t)(u.pm * BM + row)) * 4 + u.pn, t, __ATOMIC_RELAXED, __HIP_MEMORY_SCOPE_AGENT); }
        asm volatile("s_waitcnt vmcnt(0)" ::: "memory");
        if (lane == 0) __hip_atomic_fetch_add(cnt + 16 * u.pm, 1u, RLX_AGENT);
        if (wid == 0) { unsigned sp = 0, dead = 0;
            while ((unsigned)__builtin_amdgcn_readfirstlane((int)__hip_atomic_load(cnt + 16 * u.pm, RLX_AGENT)) < 32u) { __builtin_amdgcn_s_sleep(2); if (++sp > (1u << 22)) { dead = 1; break; } }
            __builtin_amdgcn_fence(__ATOMIC_ACQUIRE, "agent");
            if (lane == 0) flag[0] = dead; }
        asm volatile("s_waitcnt vmcnt(0) lgkmcnt(0)\n\ts_barrier" ::: "memory");
        if (lane < 32) { const float* sl = xch + ((size_t)(u.pm * BM + row)) * 4;
            const float t0 = __hip_atomic_load(sl + 0, RLX_AGENT), t1 = __hip_atomic_load(sl + 1, RLX_AGENT), t2 = __hip_atomic_load(sl + 2, RLX_AGENT), t3 = __hip_atomic_load(sl + 3, RLX_AGENT);
            float rs = 1.0f / sqrtf(((t0 + t1) + (t2 + t3)) * (1.f / D) + RMS_EPS); if (flag[0]) rs = __builtin_nanf("");
            S[row] = rs; }
        asm volatile("s_waitcnt vmcnt(0) lgkmcnt(0)\n\ts_barrier" ::: "memory");
        f32x4 gv[2][2];
#pragma unroll
        for (int bj = 0; bj < 2; ++bj)
#pragma unroll
            for (int n = 0; n < 2; ++n) gv[bj][n] = *(const f32x4*)(g + col0 + bj * HALF + n * 4);
#pragma unroll
        for (int ai = 0; ai < 2; ++ai)
#pragma unroll
            for (int m = 0; m < 4; ++m) { const int r = ai * HALF + wr * 64 + m * 16 + fr; const float rs = S[r]; bf16* hp = H + (size_t)(u.pm * BM + r) * D + col0;
#pragma unroll
                for (int bj = 0; bj < 2; ++bj) *(u32x4*)(hp + bj * HALF) = pack8(acc[ai][bj][m][0] * rs * gv[bj][0], acc[ai][bj][m][1] * rs * gv[bj][1]); }
        asm volatile("s_waitcnt lgkmcnt(0)\n\ts_barrier" ::: "memory");
    }
};
struct EpiMerge2 {
    static constexpr bool PERM = true;
    static constexpr int SLACK = 16;
    const bf16* G; bf16* O;
    __device__ __forceinline__ bool keep(const Unit& u) const { return u.sub == 0; }
    __device__ __forceinline__ void operator()(f32x4 (&acc)[2][2][4][2], const Unit& u, int wr, int wc, int fr, int fq) const {
        const int row0 = u.pm * BM + wr * 64 + fr, col = u.pn * BM + 32 * wc + 8 * fq;
#pragma unroll
        for (int ai = 0; ai < 2; ++ai) { u32x4 gbv[4][2], gav[4][2];
#pragma unroll
            for (int m = 0; m < 4; ++m) { const size_t r = (size_t)(row0 + ai * HALF + m * 16);
#pragma unroll
                for (int bj = 0; bj < 2; ++bj) { gbv[m][bj] = *(const u32x4*)(G + r * (2 * D) + D + col + bj * HALF); if (u.sub == 0) gav[m][bj] = *(const u32x4*)(G + r * (2 * D) + col + bj * HALF); } }
#pragma unroll
            for (int m = 0; m < 4; ++m) { const size_t r = (size_t)(row0 + ai * HALF + m * 16);
#pragma unroll
                for (int bj = 0; bj < 2; ++bj) { f32x4 gb0, gb1; unpack8(gbv[m][bj], gb0, gb1);
                    if (u.sub == 0) { f32x4 ga0, ga1; unpack8(gav[m][bj], ga0, ga1);
#pragma unroll
                        for (int j = 0; j < 4; ++j) { acc[ai][bj][m][0][j] *= gb0[j] * __builtin_amdgcn_rcpf(ga0[j]); acc[ai][bj][m][1][j] *= gb1[j] * __builtin_amdgcn_rcpf(ga1[j]); } }
                    else { f32x4 r0, r1;
#pragma unroll
                        for (int j = 0; j < 4; ++j) { r0[j] = __builtin_amdgcn_rcpf(gb0[j]); r1[j] = __builtin_amdgcn_rcpf(gb1[j]); }
                        *(u32x4*)(O + r * D + col + bj * HALF) = pack8(acc[ai][bj][m][0] * r0, acc[ai][bj][m][1] * r1); } } } }
    }
};

struct SchedMoe {
    TileOrder o; const char* A; const char* B; int lda, ldb, ntk, rt0; size_t estride; bool a_chunk_local; int ts1, ts2, ts3, ts4, ts5, ts6, ts7; size_t kA = BK * 2, kB = BK * 2, atile = 0, btile = 0;
    __device__ __forceinline__ void rowmajor() { kA = kB = BK * 2; atile = (size_t)BM * lda * 2; btile = (size_t)BM * ldb * 2; }
    __device__ __forceinline__ void tiled() { lda = ldb = BK; kA = kB = KT_BYTES; atile = btile = (size_t)ntk * KT_BYTES; }
    __device__ __forceinline__ bool next(int i, Unit& u) const { const bool ok = o.tile(i, u.pm, u.pn); if (!ok) return false;
        const int rt = rt0 + u.pm; u.aux = rt; u.sub = (rt >= ts1) + (rt >= ts2) + (rt >= ts3) + (rt >= ts4) + (rt >= ts5) + (rt >= ts6) + (rt >= ts7); return true; }
    __device__ __forceinline__ const char* aptr(const Unit& u) const { return A + (size_t)(a_chunk_local ? u.pm : u.aux) * atile; }
    __device__ __forceinline__ const char* bptr(const Unit& u) const { return B + (size_t)u.sub * estride + (size_t)u.pn * btile; }
    __device__ __forceinline__ int nt(const Unit&) const { return ntk; }
};
struct EpiMoeDown2 {
    static constexpr bool PERM = false;
    static constexpr int SLACK = 0;
    float* x; const int* tokrow; const float* wrow;
    __device__ __forceinline__ bool keep(const Unit&) const { return false; }
    __device__ __forceinline__ void operator()(f32x4 (&acc)[2][2][4][2], const Unit& u, int wr, int wc, int fr, int fq) const {
        const int row0 = u.aux * BM + wr * 64 + fr, col0 = u.pn * BM + wc * 32 + 4 * fq;
        int tok[2][4]; float w[2][4];
#pragma unroll
        for (int ai = 0; ai < 2; ++ai)
#pragma unroll
            for (int m = 0; m < 4; ++m) { const int srow = row0 + ai * HALF + m * 16; tok[ai][m] = tokrow[srow]; w[ai][m] = wrow[srow]; }
#pragma unroll
        for (int ai = 0; ai < 2; ++ai) { f32x4 b[4][2][2];
#pragma unroll
            for (int m = 0; m < 4; ++m) { const float* xp = x + (size_t)(tok[ai][m] < 0 ? 0 : tok[ai][m]) * D + col0;
#pragma unroll
                for (int bj = 0; bj < 2; ++bj)
#pragma unroll
                    for (int n = 0; n < 2; ++n) b[m][bj][n] = *(const f32x4*)(xp + bj * HALF + n * 16); }
#pragma unroll
            for (int m = 0; m < 4; ++m) if (tok[ai][m] >= 0) { float* xp = x + (size_t)tok[ai][m] * D + col0;
#pragma unroll
                for (int bj = 0; bj < 2; ++bj)
#pragma unroll
                    for (int n = 0; n < 2; ++n) *(f32x4*)(xp + bj * HALF + n * 16) = b[m][bj][n] + acc[ai][bj][m][n] * w[ai][m]; } }
    }
};

struct EpiMoeDownA {
    static constexpr bool PERM = true;
    static constexpr int SLACK = 16;
    bf16* PA; const float* wrow;
    __device__ __forceinline__ bool keep(const Unit&) const { return false; }
    __device__ __forceinline__ void operator()(f32x4 (&acc)[2][2][4][2], const Unit& u, int wr, int wc, int fr, int fq) const {
        const int row0 = u.aux * BM + wr * 64 + fr, col0 = u.pn * BM + 32 * wc + 8 * fq;
#pragma unroll
        for (int ai = 0; ai < 2; ++ai)
#pragma unroll
            for (int m = 0; m < 4; ++m) { const int srow = row0 + ai * HALF + m * 16; const float w = wrow[srow]; bf16* p = PA + (size_t)srow * D + col0;
#pragma unroll
                for (int bj = 0; bj < 2; ++bj) *(u32x4*)(p + bj * HALF) = pack8(acc[ai][bj][m][0] * w, acc[ai][bj][m][1] * w); }
    }
};
struct EpiMoeDownNorm {
    static constexpr bool PERM = false;
    static constexpr int SLACK = 0;
    float* x; const int* tokrow; const float* wrow; const float* g; float* xch; gu32* cnt; LAS unsigned char* tab; const bf16* PA; const int* tokposA;
    __device__ __forceinline__ bool keep(const Unit&) const { return false; }
    __device__ __forceinline__ void operator()(f32x4 (&acc)[2][2][4][2], const Unit& u, int wr, int wc, int fr, int fq) const {
        const int wid = wr * 4 + wc, lane = fr + 16 * fq;
        const int row0 = u.aux * BM + wr * 64 + fr, col0 = u.pn * BM + wc * 32 + 4 * fq;
        LAS float* P = (LAS float*)tab; LAS float* S = P + 1024; LAS unsigned* flag = (LAS unsigned*)(S + 256);
        int tok[2][4]; float w[2][4]; int pa[2][4];
#pragma unroll
        for (int ai = 0; ai < 2; ++ai)
#pragma unroll
            for (int m = 0; m < 4; ++m) { const int srow = row0 + ai * HALF + m * 16; tok[ai][m] = tokrow[srow]; w[ai][m] = wrow[srow]; }
#pragma unroll
        for (int ai = 0; ai < 2; ++ai)
#pragma unroll
            for (int m = 0; m < 4; ++m) pa[ai][m] = tokposA[tok[ai][m] < 0 ? 0 : tok[ai][m]];
#pragma unroll
        for (int am = 0; am < 4; ++am) { const int ai = am >> 1; f32x4 b[4][2][2]; u32x2 pv[4][2][2];
#pragma unroll
            for (int m = 2 * (am & 1); m < 2 * (am & 1) + 2; ++m) { const float* xp = x + (size_t)(tok[ai][m] < 0 ? 0 : tok[ai][m]) * D + col0; const bf16* pp = PA + (size_t)pa[ai][m] * D + col0;
#pragma unroll
                for (int bj = 0; bj < 2; ++bj)
#pragma unroll
                    for (int n = 0; n < 2; ++n) { b[m][bj][n] = *(const f32x4*)(xp + bj * HALF + n * 16); pv[m][bj][n] = *(const u32x2*)(pp + bj * HALF + n * 16); } }
#pragma unroll
            for (int m = 2 * (am & 1); m < 2 * (am & 1) + 2; ++m) { float q = 0.f;
#pragma unroll
                for (int bj = 0; bj < 2; ++bj)
#pragma unroll
                    for (int n = 0; n < 2; ++n) { const u32x2 pw = pv[m][bj][n]; const f32x4 pf = {__uint_as_float(pw.x << 16), __uint_as_float(pw.x & 0xffff0000u), __uint_as_float(pw.y << 16), __uint_as_float(pw.y & 0xffff0000u)};
                        const f32x4 v = (b[m][bj][n] + pf) + acc[ai][bj][m][n] * w[ai][m]; acc[ai][bj][m][n] = v; q += (v[0] * v[0] + v[1] * v[1]) + (v[2] * v[2] + v[3] * v[3]); }
                q += xor_lane<16>(q); { auto rr = __builtin_amdgcn_permlane32_swap(__float_as_uint(q), __float_as_uint(q), false, false); q = __uint_as_float(rr[0]) + __uint_as_float(rr[1]); }
                if (fq == 0) P[(ai * HALF + wr * 64 + m * 16 + fr) * 4 + wc] = q; } }
        asm volatile("s_waitcnt lgkmcnt(0)\n\ts_barrier" ::: "memory");
        const int row = wid * 32 + (lane & 31);
        if (lane < 32) { const float t = (P[row * 4 + 0] + P[row * 4 + 1]) + (P[row * 4 + 2] + P[row * 4 + 3]);
            __hip_atomic_store(xch + ((size_t)(u.aux * BM + row)) * 4 + u.pn, t, __ATOMIC_RELAXED, __HIP_MEMORY_SCOPE_AGENT); }
        asm volatile("s_waitcnt vmcnt(0)" ::: "memory");
        if (lane == 0) __hip_atomic_fetch_add(cnt + 16 * u.aux, 1u, RLX_AGENT);
        if (wid == 0) { unsigned sp = 0, dead = 0;
            while ((unsigned)__builtin_amdgcn_readfirstlane((int)__hip_atomic_load(cnt + 16 * u.aux, RLX_AGENT)) < 32u) { __builtin_amdgcn_s_sleep(2); if (++sp > (1u << 22)) { dead = 1; break; } }
            __builtin_amdgcn_fence(__ATOMIC_ACQUIRE, "agent");
            if (lane == 0) flag[0] = dead; }
        asm volatile("s_waitcnt vmcnt(0) lgkmcnt(0)\n\ts_barrier" ::: "memory");
        if (lane < 32) { const float* sl = xch + ((size_t)(u.aux * BM + row)) * 4;
            const float t0 = __hip_atomic_load(sl + 0, RLX_AGENT), t1 = __hip_atomic_load(sl + 1, RLX_AGENT), t2 = __hip_atomic_load(sl + 2, RLX_AGENT), t3 = __hip_atomic_load(sl + 3, RLX_AGENT);
            float rs = 1.0f / sqrtf(((t0 + t1) + (t2 + t3)) * (1.f / D) + RMS_EPS); if (flag[0]) rs = __builtin_nanf("");
            S[row] = rs; }
        asm volatile("s_waitcnt vmcnt(0) lgkmcnt(0)\n\ts_barrier" ::: "memory");
        f32x4 gv[2][2];
#pragma unroll
        for (int bj = 0; bj < 2; ++bj)
#pragma unroll
            for (int n = 0; n < 2; ++n) gv[bj][n] = *(const f32x4*)(g + col0 + bj * HALF + n * 16);
#pragma unroll
        for (int ai = 0; ai < 2; ++ai)
#pragma unroll
            for (int m = 0; m < 4; ++m) if (tok[ai][m] >= 0) { const float rs = S[ai * HALF + wr * 64 + m * 16 + fr]; float* xp = x + (size_t)tok[ai][m] * D + col0;
#pragma unroll
                for (int bj = 0; bj < 2; ++bj)
#pragma unroll
                    for (int n = 0; n < 2; ++n) *(f32x4*)(xp + bj * HALF + n * 16) = acc[ai][bj][m][n] * rs * gv[bj][n]; }
        asm volatile("s_waitcnt lgkmcnt(0)\n\ts_barrier" ::: "memory");
    }
};

__device__ __forceinline__ const char* uni_ptr(const char* p) { const unsigned l = __builtin_amdgcn_readfirstlane((int)(unsigned)(size_t)p), h = __builtin_amdgcn_readfirstlane((int)(unsigned)((size_t)p >> 32)); return (const char*)(((size_t)h << 32) | l); }
template <int N> __device__ __forceinline__ void wait_v() { asm volatile("s_waitcnt vmcnt(%0)" :: "n"(N) : "memory"); }
template <class Epi, class Sched, bool ALIGN_EPI, int SLK = 0>
__device__ __forceinline__ void gemm_phase(LAS unsigned char* lds, const Sched& S, const Epi& E, const int wave_id) {
    int tid_ = wave_id * 64 + lane_now();
    const int tid = tid_, wid = wave_id, lane = tid & 63, wr = wid >> 2, wc = wid & 3, fr = lane & 15, fq = lane >> 4;
    const int lda = S.lda, ldb = S.ldb;
    unsigned voffA[2], voffB[2];
#pragma unroll
    for (int i = 0; i < 2; ++i) { int R, C; stage_rc(tid * 16 + i * 8192, R, C); const int Rb = Epi::PERM ? ((R & ~31) + perm32(R & 31)) : R;
        voffA[i] = (unsigned)(R * lda + C) * 2u; voffB[i] = (unsigned)(Rb * ldb + C) * 2u; }
    const size_t kA = S.kA, kB = S.kB;
    const size_t hstepA = (size_t)HALF * lda * 2, hstepB = (size_t)HALF * ldb * 2;
    const unsigned ldsw = (unsigned)wid * 1024u;
    const int aoff = lds_byte(wr * 64 + fr, fq * 8), boff = lds_byte(wc * 32 + fr, fq * 8);
#define PG8_SA(b, h) (((b) * 2 + (h)) * HTB)
#define PG8_SB(b, h) ((4 + (b) * 2 + (h)) * HTB)
#define PG8_STAGE(bufoff, gbase, voff) do { _Pragma("unroll") for (int _i = 0; _i < 2; ++_i) \
        __builtin_amdgcn_global_load_lds((const unsigned*)((const char*)(gbase) + (voff)[_i]), (LAS unsigned*)(lds + (bufoff) + ldsw + _i * 8192), 16, 0, 0); } while (0)
#define PG8_LDA(dst, b, h) do { _Pragma("unroll") for (int m = 0; m < 4; ++m) _Pragma("unroll") for (int k = 0; k < 2; ++k) dst[m][k] = *(const LAS bf16x8*)(lds + PG8_SA(b, h) + aoff + m * 2048 + k * 1024); } while (0)
#define PG8_LDB(dst, b, h) do { _Pragma("unroll") for (int n = 0; n < 2; ++n) _Pragma("unroll") for (int k = 0; k < 2; ++k) dst[n][k] = *(const LAS bf16x8*)(lds + PG8_SB(b, h) + boff + n * 2048 + k * 1024); } while (0)
#define PG8_MMA(ai, bj, At, Bt) do { __builtin_amdgcn_s_setprio(1); _Pragma("unroll") for (int m = 0; m < 4; ++m) _Pragma("unroll") for (int n = 0; n < 2; ++n) _Pragma("unroll") for (int k = 0; k < 2; ++k) \
        acc[ai][bj][m][n] = __builtin_amdgcn_mfma_f32_16x16x32_bf16(Bt[n][k], At[m][k], acc[ai][bj][m][n], 0, 0, 0); __builtin_amdgcn_s_setprio(0); } while (0)
#define PG8_WAIT_V(n) asm volatile("s_waitcnt vmcnt(" #n ")" ::: "memory")
#define PG8_WAIT_L(n) asm volatile("s_waitcnt lgkmcnt(" #n ")" ::: "memory")
#define PG8_BAR __builtin_amdgcn_s_barrier()
#define PG8_SCHED __builtin_amdgcn_sched_barrier(0)
    LAS unsigned* utab = (LAS unsigned*)(lds + RING_BYTES);
    if (wid == 0) { Unit u; const bool ok = S.next(lane, u); utab[lane] = ok ? ((unsigned)u.pm | (unsigned)u.pn << 10 | (unsigned)u.sub << 16 | (unsigned)u.aux << 20) : 0xffffffffu; }
    asm volatile("s_waitcnt lgkmcnt(0)" ::: "memory");
    __builtin_amdgcn_s_barrier();
#define PG8_UNIT(i, u, ok) do { unsigned w_ = utab[(i) & 63]; w_ = (unsigned)__builtin_amdgcn_readfirstlane((int)w_); ok = (i) < 64 && w_ != 0xffffffffu; \
        u.pm = (int)(w_ & 1023u); u.pn = (int)((w_ >> 10) & 63u); u.sub = (int)((w_ >> 16) & 15u); u.aux = (int)(w_ >> 20); } while (0)
    Unit cur, nxt; int ui = 0;
    { bool ok0; PG8_UNIT(0, cur, ok0); if (!ok0) return; }
    f32x4 acc[2][2][4][2];
#pragma unroll
    for (int a = 0; a < 2; ++a)
#pragma unroll
        for (int b = 0; b < 2; ++b)
#pragma unroll
            for (int m = 0; m < 4; ++m)
#pragma unroll
                for (int n = 0; n < 2; ++n) acc[a][b][m][n] = (f32x4){0.f, 0.f, 0.f, 0.f};
    bf16x8 At[4][2], B0[2][2], B1[2][2];
    const char* cA = S.aptr(cur); const char* cB = S.bptr(cur);
    PG8_STAGE(PG8_SB(0, 0), cB, voffB); PG8_STAGE(PG8_SB(0, 1), cB + hstepB, voffB); PG8_STAGE(PG8_SA(0, 0), cA, voffA); PG8_STAGE(PG8_SA(0, 1), cA + hstepA, voffA);
    if (wr == 1) PG8_BAR;
    PG8_WAIT_V(2); PG8_BAR;
    PG8_STAGE(PG8_SB(1, 0), cB + kB, voffB); PG8_STAGE(PG8_SA(1, 0), cA + kA, voffA); PG8_STAGE(PG8_SB(1, 1), cB + hstepB + kB, voffB);
    if constexpr (SLK > 0) { PG8_STAGE(PG8_SA(1, 1), cA + kA + hstepA, voffA); PG8_WAIT_V(0); } else PG8_WAIT_V(6);
    PG8_BAR;
    for (;;) {
        bool has_next; PG8_UNIT(ui + 1, nxt, has_next);
        const char* nA = has_next ? S.aptr(nxt) : cA; const char* nB = has_next ? S.bptr(nxt) : cB;
        if constexpr (SLK > 0) { nA = uni_ptr(nA); nB = uni_ptr(nB); }
        const int nt = S.nt(cur);
#define PG8_PAIR(WV) do { \
            PG8_LDB(B0, 0, 0); PG8_LDB(B1, 0, 1); PG8_SCHED; PG8_LDA(At, 0, 0); PG8_STAGE(PG8_SA(1, 1), a1 + hstepA, voffA); \
            WV; PG8_WAIT_L(0); PG8_BAR; PG8_MMA(0, 0, At, B0); PG8_MMA(0, 1, At, B1); PG8_BAR; PG8_SCHED; \
            PG8_LDA(At, 0, 1); PG8_STAGE(PG8_SB(0, 0), b2, voffB); PG8_STAGE(PG8_SB(0, 1), b2 + hstepB, voffB); PG8_STAGE(PG8_SA(0, 0), a2, voffA); \
            WV; PG8_WAIT_L(0); PG8_BAR; PG8_MMA(1, 0, At, B0); PG8_MMA(1, 1, At, B1); PG8_BAR; PG8_SCHED; \
            PG8_LDB(B0, 1, 0); PG8_LDB(B1, 1, 1); PG8_SCHED; PG8_LDA(At, 1, 0); PG8_STAGE(PG8_SA(0, 1), a2 + hstepA, voffA); \
            PG8_WAIT_V(8); PG8_WAIT_L(0); PG8_BAR; PG8_MMA(0, 0, At, B0); PG8_MMA(0, 1, At, B1); PG8_BAR; PG8_SCHED; \
            PG8_LDA(At, 1, 1); PG8_STAGE(PG8_SB(1, 0), b3, voffB); PG8_STAGE(PG8_SB(1, 1), b3 + hstepB, voffB); PG8_STAGE(PG8_SA(1, 0), a3, voffA); \
            PG8_WAIT_V(8); PG8_WAIT_L(0); PG8_BAR; PG8_MMA(1, 0, At, B0); PG8_MMA(1, 1, At, B1); PG8_BAR; PG8_SCHED; } while (0)
        if constexpr (SLK > 0) {
            const char* a2 = cA + 2 * kA; const char* b2 = cB + 2 * kB; const char* a3 = a2 + kA; const char* b3 = b2 + kB;
            PG8_LDB(B0, 0, 0); PG8_LDB(B1, 0, 1); PG8_SCHED; PG8_LDA(At, 0, 0);
            wait_v<8 + SLK>(); PG8_WAIT_L(0); PG8_BAR; PG8_MMA(0, 0, At, B0); PG8_MMA(0, 1, At, B1); PG8_BAR; PG8_SCHED;
            PG8_LDA(At, 0, 1); PG8_STAGE(PG8_SB(0, 0), b2, voffB); PG8_STAGE(PG8_SB(0, 1), b2 + hstepB, voffB); PG8_STAGE(PG8_SA(0, 0), a2, voffA);
            wait_v<8 + SLK>(); PG8_WAIT_L(0); PG8_BAR; PG8_MMA(1, 0, At, B0); PG8_MMA(1, 1, At, B1); PG8_BAR; PG8_SCHED;
            PG8_LDB(B0, 1, 0); PG8_LDB(B1, 1, 1); PG8_SCHED; PG8_LDA(At, 1, 0); PG8_STAGE(PG8_SA(0, 1), a2 + hstepA, voffA);
            wait_v<8 + SLK>(); PG8_WAIT_L(0); PG8_BAR; PG8_MMA(0, 0, At, B0); PG8_MMA(0, 1, At, B1); PG8_BAR; PG8_SCHED;
            PG8_LDA(At, 1, 1); PG8_STAGE(PG8_SB(1, 0), b3, voffB); PG8_STAGE(PG8_SB(1, 1), b3 + hstepB, voffB); PG8_STAGE(PG8_SA(1, 0), a3, voffA);
            PG8_WAIT_V(8); PG8_WAIT_L(0); PG8_BAR; PG8_MMA(1, 0, At, B0); PG8_MMA(1, 1, At, B1); PG8_BAR; PG8_SCHED;
        }
        for (int t = SLK > 0 ? 2 : 0; t < nt; t += 2) {
            const bool last = (t == nt - 2);
            const char* a1 = cA + (size_t)(t + 1) * kA;
            const char* a2 = last ? nA : cA + (size_t)(t + 2) * kA; const char* b2 = last ? nB : cB + (size_t)(t + 2) * kB;
            const char* a3 = a2 + kA; const char* b3 = b2 + kB;
            PG8_PAIR(PG8_WAIT_V(8));
        }
#undef PG8_PAIR
        if constexpr (SLK > 0) PG8_STAGE(PG8_SA(1, 1), nA + kA + hstepA, voffA);
        if constexpr (ALIGN_EPI) { if (wr == 0) PG8_BAR; }
        if constexpr (SLK > 0) { int le; asm volatile("v_mbcnt_lo_u32_b32 %0, -1, 0\n\tv_mbcnt_hi_u32_b32 %0, -1, %0" : "=v"(le)); E(acc, cur, wr, wc, le & 15, le >> 4); } else E(acc, cur, wr, wc, fr, fq);
        if (!has_next) break;
        if (!E.keep(cur)) {
#pragma unroll
            for (int a = 0; a < 2; ++a)
#pragma unroll
                for (int b = 0; b < 2; ++b)
#pragma unroll
                    for (int m = 0; m < 4; ++m)
#pragma unroll
                        for (int n = 0; n < 2; ++n) acc[a][b][m][n] = (f32x4){0.f, 0.f, 0.f, 0.f};
        }
        cur = nxt; cA = nA; cB = nB; ++ui;
        if constexpr (SLK > 0) { unsigned al = __builtin_amdgcn_readfirstlane((int)(unsigned)(size_t)cA), ah = __builtin_amdgcn_readfirstlane((int)(unsigned)((size_t)cA >> 32)), bl = __builtin_amdgcn_readfirstlane((int)(unsigned)(size_t)cB), bh = __builtin_amdgcn_readfirstlane((int)(unsigned)((size_t)cB >> 32));
          asm volatile("" : "+s"(al), "+s"(ah), "+s"(bl), "+s"(bh));
          cA = (const char*)(((size_t)ah << 32) | al); cB = (const char*)(((size_t)bh << 32) | bl); }
        if constexpr (ALIGN_EPI) { if (wr == 1) PG8_BAR; }
    }
    PG8_WAIT_V(0);
    if constexpr (!ALIGN_EPI) { if (wr == 0) PG8_BAR; }
    PG8_BAR;
#undef PG8_UNIT
#undef PG8_SA
#undef PG8_SB
#undef PG8_STAGE
#undef PG8_LDA
#undef PG8_LDB
#undef PG8_MMA
#undef PG8_WAIT_V
#undef PG8_WAIT_L
#undef PG8_BAR
#undef PG8_SCHED
}
}

constexpr int BM_ROWS = 256;
template <int MAP>
__device__ __forceinline__ void convert_job(const float* W, int K, int N, bf16* WT, int dpitch, int dcol0, LAS float* scr, int gw, int NGW, int lane, const bool tiled = false, const float scale = 1.f) {
    const int nblk = N / 32, nitems = (K / 64) * nblk;
    float v[32];
    int it = gw;
    if (it < nitems) { const float* src = W + (size_t)(64 * (it / nblk) + (lane >> 5)) * N + 32 * (it % nblk) + (lane & 31);
#pragma unroll
        for (int i = 0; i < 32; ++i) v[i] = src[(size_t)(2 * i) * N]; }
    for (; it < nitems; it += NGW) {
        const int kb = it / nblk, nb = it % nblk, k0 = 64 * kb, n0 = 32 * nb;
        int drow0 = n0;
        if (MAP == 1) { if (n0 < NQKV) { const int q = (n0 & 255) >> 5; drow0 = (n0 & ~255) + 128 * (q & 1) + 32 * (q >> 1); } }
        if (MAP == 2) drow0 = 256 * (n0 >> 7) + (n0 & 127);
        if (MAP == 3) drow0 = 256 * (n0 >> 7) + 128 + (n0 & 127);
#pragma unroll
        for (int i = 0; i < 32; ++i) scr[(2 * i + (lane >> 5)) * 33 + (lane & 31)] = v[i];
        const int nx = it + NGW;
        if (nx < nitems) { const float* src = W + (size_t)(64 * (nx / nblk) + (lane >> 5)) * N + 32 * (nx % nblk) + (lane & 31);
#pragma unroll
            for (int i = 0; i < 32; ++i) v[i] = src[(size_t)(2 * i) * N]; }
        asm volatile("s_waitcnt lgkmcnt(0)" ::: "memory");
        const int c = lane & 7;
#pragma unroll
        for (int j = 0; j < 4; ++j) { const int n = (lane >> 3) + 8 * j; const LAS float* s = scr + (8 * c) * 33 + n;
            const float sc = (MAP == 1) ? (n0 >= NQKV ? 1.4426950408889634f : 1.f) : scale;
            u32x4 o; o.x = pk2(s[0 * 33] * sc, s[1 * 33] * sc); o.y = pk2(s[2 * 33] * sc, s[3 * 33] * sc); o.z = pk2(s[4 * 33] * sc, s[5 * 33] * sc); o.w = pk2(s[6 * 33] * sc, s[7 * 33] * sc);
            const int dr = drow0 + n;
            if (tiled) *(u32x4*)(WT + (((size_t)(dr >> 8) * (K >> 6) + kb) * BM_ROWS + (dr & 255)) * 64 + 8 * c) = o;
            else *(u32x4*)(WT + (size_t)dr * dpitch + dcol0 + k0 + 8 * c) = o; }
        asm volatile("s_waitcnt lgkmcnt(0)" ::: "memory");
    }
}

template <bool ROUTER>
__device__ __forceinline__ void norm_phase(const float* x, const float* g, bf16* H, const float* wr, int* tk_e, float* tk_w, LAS unsigned* lcnt, const int wv) {
    int t_ = wv * 64 + lane_now(); const int lane = t_ & 63, wave = __builtin_amdgcn_readfirstlane(t_ >> 6); (void)lane; (void)wave;
    const int gw = blockIdx.x * NWAVES + wave, NGW = gridDim.x * NWAVES;
    f32x4 gv[4];
#pragma unroll
    for (int j = 0; j < 4; ++j) gv[j] = *((const f32x4*)g + lane + 64 * j);
    f32x4 rw[ROUTER ? 16 : 1][2];
    if (ROUTER) {
#pragma unroll
        for (int j = 0; j < 4; ++j)
#pragma unroll
            for (int c = 0; c < 4; ++c) { const float* w = wr + (size_t)(256 * j + 4 * lane + c) * NEXP; rw[j * 4 + c][0] = *(const f32x4*)w; rw[j * 4 + c][1] = *(const f32x4*)(w + 4); } }
    f32x4 v[4], vn[4];
    if (gw < M) {
#pragma unroll
        for (int j = 0; j < 4; ++j) v[j] = ((const f32x4*)(x + (size_t)gw * D) + lane)[64 * j]; }
    for (int m = gw; m < M; m += NGW) {
        if (m + NGW < M) {
#pragma unroll
            for (int j = 0; j < 4; ++j) vn[j] = ((const f32x4*)(x + (size_t)(m + NGW) * D) + lane)[64 * j]; }
        float s = 0.f;
#pragma unroll
        for (int j = 0; j < 4; ++j) s += (v[j].x * v[j].x + v[j].y * v[j].y) + (v[j].z * v[j].z + v[j].w * v[j].w);
        const float rstd = 1.0f / sqrtf(wave_sum(s) * (1.f / D) + RMS_EPS);
#pragma unroll
        for (int j = 0; j < 4; ++j) v[j] = v[j] * rstd * gv[j];
        u32x2* o = (u32x2*)(H + (size_t)m * D) + lane;
#pragma unroll
        for (int j = 0; j < 4; ++j) { u32x2 w; w.x = pk2(v[j].x, v[j].y); w.y = pk2(v[j].z, v[j].w); o[64 * j] = w; }
        if (ROUTER) {
            float lg[NEXP];
#pragma unroll
            for (int e = 0; e < NEXP; ++e) lg[e] = 0.f;
#pragma unroll
            for (int j = 0; j < 4; ++j)
#pragma unroll
                for (int c = 0; c < 4; ++c) { const f32x4 w0 = rw[j * 4 + c][0], w1 = rw[j * 4 + c][1];
                    const float hv = v[j][c];
                    lg[0] = fmaf(hv, w0.x, lg[0]); lg[1] = fmaf(hv, w0.y, lg[1]); lg[2] = fmaf(hv, w0.z, lg[2]); lg[3] = fmaf(hv, w0.w, lg[3]);
                    lg[4] = fmaf(hv, w1.x, lg[4]); lg[5] = fmaf(hv, w1.y, lg[5]); lg[6] = fmaf(hv, w1.z, lg[6]); lg[7] = fmaf(hv, w1.w, lg[7]); }
#pragma unroll
            for (int e = 0; e < NEXP; ++e) lg[e] = wave_sum(lg[e]);
            int i0 = 0; float v0 = lg[0];
#pragma unroll
            for (int e = 1; e < NEXP; ++e) if (lg[e] > v0) { v0 = lg[e]; i0 = e; }
            int i1 = -1; float v1 = -INFINITY;
#pragma unroll
            for (int e = 0; e < NEXP; ++e) if (e != i0 && lg[e] > v1) { v1 = lg[e]; i1 = e; }
            const float w0 = 1.f / (1.f + expf(v1 - v0)), w1 = 1.f - w0;
            const int lo = i0 < i1 ? i0 : i1, hi = i0 < i1 ? i1 : i0;
            if (lane == 0) { tk_e[m] = lo | (hi << 8); tk_w[2 * m] = i0 < i1 ? w0 : w1; tk_w[2 * m + 1] = i0 < i1 ? w1 : w0;
                __hip_atomic_fetch_add(&lcnt[lo], 1u, __ATOMIC_RELAXED, __HIP_MEMORY_SCOPE_WORKGROUP); __hip_atomic_fetch_add(&lcnt[8 + hi], 1u, __ATOMIC_RELAXED, __HIP_MEMORY_SCOPE_WORKGROUP); }
        }
#pragma unroll
        for (int j = 0; j < 4; ++j) v[j] = vn[j];
    }
}
__device__ __forceinline__ void final_norm_phase(float* x, const float* g, int, const int wv) {
    int t_ = wv * 64 + lane_now(); const int lane = t_ & 63, wave = __builtin_amdgcn_readfirstlane(t_ >> 6); (void)lane; (void)wave;
    const int gw = blockIdx.x * NWAVES + wave, NGW = gridDim.x * NWAVES;
    f32x4 gv[4];
#pragma unroll
    for (int j = 0; j < 4; ++j) gv[j] = *((const f32x4*)g + lane + 64 * j);
    f32x4 v[4], vn[4];
    if (gw < M) {
#pragma unroll
        for (int j = 0; j < 4; ++j) v[j] = ((const f32x4*)(x + (size_t)gw * D) + lane)[64 * j]; }
    for (int m = gw; m < M; m += NGW) {
        if (m + NGW < M) {
#pragma unroll
            for (int j = 0; j < 4; ++j) vn[j] = ((const f32x4*)(x + (size_t)(m + NGW) * D) + lane)[64 * j]; }
        f32x4* xr = (f32x4*)(x + (size_t)m * D) + lane; float s = 0.f;
#pragma unroll
        for (int j = 0; j < 4; ++j) s += (v[j].x * v[j].x + v[j].y * v[j].y) + (v[j].z * v[j].z + v[j].w * v[j].w);
        const float rstd = 1.0f / sqrtf(wave_sum(s) * (1.f / D) + RMS_EPS);
#pragma unroll
        for (int j = 0; j < 4; ++j) xr[64 * j] = v[j] * rstd * gv[j];
#pragma unroll
        for (int j = 0; j < 4; ++j) v[j] = vn[j];
    }
}
__device__ __forceinline__ void moe_dispatch_phase(LAS unsigned char* lds, const bf16* H, bf16* Hs, const int* tk_e, const float* tk_w, int* tokrow, float* wrow, gu32* ctl, int* tokposA, const int wv) {
    int t_ = wv * 64 + lane_now(); const int tid = t_;
    LAS int* elo = (LAS int*)lds; LAS int* ehi = elo + 128; LAS int* posA = ehi + 128; LAS int* posB = posA + 128; LAS int* base = posB + 128; LAS int* seg = base + 16;
    if (tid < 16) { int s = 0;
#pragma unroll
        for (int e = 0; e < 7; ++e) { const int c_ = (int)((__hip_atomic_load(ctl + CW_CNT + (tid & 8) + e, RLX_AGENT) + 255u) & ~255u); s += e < (tid & 7) ? c_ : 0; }
        seg[tid] = s; }
    for (int ch = blockIdx.x; ch < M / 128; ch += gridDim.x) {
        __syncthreads();
        u32x4 v0[16];
#pragma unroll
        for (int q = 0; q < 16; ++q) v0[q] = *((const u32x4*)(H + (size_t)(ch * 128 + (tid >> 7) + 4 * q) * D) + (tid & 127));
        if (tid < 128) { const int e = tk_e[ch * 128 + tid]; elo[tid] = e & 255; ehi[tid] = e >> 8; }
        __syncthreads();
        int rA = 0, rB = 0;
        if (tid < 128) { const int lo = elo[tid], hi = ehi[tid]; for (int j = 0; j < tid; ++j) { rA += (elo[j] == lo); rB += (ehi[j] == hi); } }
        if (tid >= 128 && tid < 144) { const int k = tid - 128; int c = 0; for (int j = 0; j < 128; ++j) c += ((k < 8 ? elo[j] : ehi[j]) == (k & 7)); base[k] = (int)__hip_atomic_fetch_add(ctl + CW_FILL + k, (unsigned)c, RLX_AGENT); }
        __syncthreads();
        if (tid < 128) { const int tok = ch * 128 + tid, lo = elo[tid], hi = ehi[tid];
            const int pA = seg[lo] + base[lo] + rA, pB = MOE_LROWS + seg[8 + hi] + base[8 + hi] + rB;
            tokrow[pA] = tok; wrow[pA] = tk_w[2 * tok]; tokrow[pB] = tok; wrow[pB] = tk_w[2 * tok + 1]; posA[tid] = pA; posB[tid] = pB; tokposA[tok] = pA; }
        __syncthreads();
        { u32x4 v1[16];
          const int j0 = tid >> 7;
#pragma unroll
          for (int q = 0; q < 16; ++q) v1[q] = *((const u32x4*)(H + (size_t)(ch * 128 + 64 + j0 + 4 * q) * D) + (tid & 127));
#pragma unroll
          for (int q = 0; q < 16; ++q) { const int j = j0 + 4 * q; *((u32x4*)(Hs + (size_t)posA[j] * D) + (tid & 127)) = v0[q]; *((u32x4*)(Hs + (size_t)posB[j] * D) + (tid & 127)) = v0[q]; }
#pragma unroll
          for (int q = 0; q < 16; ++q) { const int j = 64 + j0 + 4 * q; *((u32x4*)(Hs + (size_t)posA[j] * D) + (tid & 127)) = v1[q]; *((u32x4*)(Hs + (size_t)posB[j] * D) + (tid & 127)) = v1[q]; } }
    }
    __syncthreads();
}


__device__ __forceinline__ void moe_router_phase(LAS unsigned char* lds, const float* X, const float* nf, bf16* H, const float* w_router, const float* wg, const float* wu, const float* wd,
                                                 int* tk_e, float* tk_w, int* tokrow, unsigned char* ws, gu32* ctl, const int wv) {
    int t_ = wv * 64 + lane_now(); const int tid = t_, lane = tid & 63, wave = __builtin_amdgcn_readfirstlane(tid >> 6);
    int G_ = gridDim.x; asm volatile("" : "+s"(G_)); const int G = G_, bid = blockIdx.x;
    LAS unsigned* lcnt = (LAS unsigned*)lds;
    if (tid < 16) lcnt[tid] = 0u;
    __syncthreads();
    norm_phase<true>(X, nf, H, w_router, tk_e, tk_w, lcnt, wv);
    __syncthreads();
    if (tid < 16) __hip_atomic_fetch_add(ctl + CW_CNT + tid, lcnt[tid], RLX_AGENT);
    for (int i = bid * NTHREADS + tid; i < 2 * MOE_LROWS; i += G * NTHREADS) tokrow[i] = -1;
    __syncthreads();
    LAS float* scr = (LAS float*)(lds + wave * 16384);
    const int gw = bid * NWAVES + wave, NGW = G * NWAVES;
    for (int e = 0; e < NEXP; ++e) {
        bf16* gu = (bf16*)(ws + WS_EXPW) + (size_t)e * 2 * FFE * D; bf16* dn = (bf16*)(ws + WS_EXPW + EXPW_DN) + (size_t)e * D * FFE;
        const int g0 = (gw + NGW - ((3 * e) * 1792) % NGW) % NGW, g1 = (gw + NGW - ((3 * e + 1) * 1792) % NGW) % NGW, g2 = (gw + NGW - ((3 * e + 2) * 1792) % NGW) % NGW;
        convert_job<2>(wg + (size_t)e * D * FFE, D, FFE, gu, D, 0, scr, g0, NGW, lane, false, 1.4426950408889634f);
        convert_job<3>(wu + (size_t)e * D * FFE, D, FFE, gu, D, 0, scr, g1, NGW, lane, false, 0.6931471805599453f);
        convert_job<0>(wd + (size_t)e * FFE * D, FFE, D, dn, FFE, 0, scr, g2, NGW, lane, true); }
}

namespace attn_body {
typedef short bf16x8 __attribute__((ext_vector_type(8)));
typedef short s16x4 __attribute__((ext_vector_type(4)));
typedef float f32x16 __attribute__((ext_vector_type(16)));
constexpr int NW = 8, QBLK = 32, QB = QBLK * NW, KVBLK = 64, PITCH = 64;
__device__ __forceinline__ int crow(int r, int hi) { return (r & 3) + 8 * (r >> 2) + 4 * hi; }
#define SBAR() __builtin_amdgcn_sched_barrier(0)
__device__ __forceinline__ void cmask(f32x16& p0, f32x16& p1, int jb, int qrel, int hi) {
    const float NEG = -INFINITY; int kb = 64 * jb + 4 * hi;
#pragma unroll
    for (int r = 0; r < 16; ++r) { int kv = kb + (r & 3) + 8 * (r >> 2); if (kv > qrel) p0[r] = NEG; if (kv + 32 > qrel) p1[r] = NEG; }
}
__device__ __forceinline__ void dmask(f32x16& p0, f32x16& p1, int tmp, unsigned wq) {
    const float NEG = -INFINITY;
#pragma unroll
    for (int r = 0; r < 16; ++r) { const int off = (r & 3) + 8 * (r >> 2); if ((unsigned)(tmp - off) > wq) p0[r] = NEG; if ((unsigned)(tmp - off - 32) > wq) p1[r] = NEG; }
}
constexpr int NSLOT = 3, SLOTB = 8192;
constexpr int LDS_K = 0, LDS_V = NSLOT * SLOTB, LDS_WS = 2 * NSLOT * SLOTB, LDS_OST = LDS_WS + NW * 64 * 4, LDS_BYTES = LDS_OST + NW * 4096;
constexpr float C2 = 0.125f * 1.4426950408889634f;
__device__ __forceinline__ void glds16(const void* gsrc, unsigned lds_dst) { unsigned keep;
    asm volatile("s_mov_b32 %0, m0\n\ts_mov_b32 m0, %2\n\ts_nop 0\n\tglobal_load_lds_dwordx4 %1, off\n\ts_mov_b32 m0, %0" : "=&s"(keep) : "v"(gsrc), "s"(lds_dst) : "memory"); }
__device__ __forceinline__ float max3f(float a, float b, float c) { float r; asm("v_max3_f32 %0, %1, %2, %3" : "=v"(r) : "v"(a), "v"(b), "v"(c)); return r; }
__device__ __forceinline__ float max2f(float a, float b) { float r; asm("v_max_f32_e32 %0, %1, %2" : "=v"(r) : "v"(a), "v"(b)); return r; }
__device__ __forceinline__ float fadd_s(float a, float b) { float r; asm("v_add_f32_e32 %0, %1, %2" : "=v"(r) : "v"(a), "v"(b)); return r; }
__device__ __forceinline__ float fsub_s(float a, float b) { float r; asm("v_sub_f32_e32 %0, %1, %2" : "=v"(r) : "v"(a), "v"(b)); return r; }
typedef float f32x2_t __attribute__((ext_vector_type(2))); typedef __bf16 bf16x2_t __attribute__((ext_vector_type(2)));
__device__ __forceinline__ unsigned cvtpk_s(float lo, float hi) { f32x2_t v = {lo, hi}; bf16x2_t b = __builtin_convertvector(v, bf16x2_t); return __builtin_bit_cast(unsigned, b); }
#define WAIT_BAR(N) asm volatile("s_waitcnt vmcnt(" #N ") lgkmcnt(0)\n\ts_barrier" ::: "memory")
__device__ __forceinline__ void qkt(f32x16& p0, f32x16& p1, const char* Kslot, const bf16x8* qr, const f32x16& negm, int r32, int hi) {
    const char* kb = Kslot + hi * 1024 + r32 * 16;
#pragma unroll
    for (int d0 = 0; d0 < 4; ++d0) {
        const bf16x8 b0 = *reinterpret_cast<const bf16x8*>(kb + d0 * 2048);
        const bf16x8 b1 = *reinterpret_cast<const bf16x8*>(kb + d0 * 2048 + 512);
        if (d0 == 0) { p0 = __builtin_amdgcn_mfma_f32_32x32x16_bf16(b0, qr[0], negm, 0, 0, 0); p1 = __builtin_amdgcn_mfma_f32_32x32x16_bf16(b1, qr[0], negm, 0, 0, 0); }
        else { p0 = __builtin_amdgcn_mfma_f32_32x32x16_bf16(b0, qr[d0], p0, 0, 0, 0); p1 = __builtin_amdgcn_mfma_f32_32x32x16_bf16(b1, qr[d0], p1, 0, 0, 0); } }
}
typedef __attribute__((address_space(3))) const char* lds_cptr;
typedef short v4i16_t __attribute__((ext_vector_type(4)));
__device__ __forceinline__ void kload8(bf16x8* kf, lds_cptr kp) {
    kf[0] = *(const __attribute__((address_space(3))) bf16x8*)(kp);        kf[1] = *(const __attribute__((address_space(3))) bf16x8*)(kp + 512);
    kf[2] = *(const __attribute__((address_space(3))) bf16x8*)(kp + 2048); kf[3] = *(const __attribute__((address_space(3))) bf16x8*)(kp + 2560);
    kf[4] = *(const __attribute__((address_space(3))) bf16x8*)(kp + 4096); kf[5] = *(const __attribute__((address_space(3))) bf16x8*)(kp + 4608);
    kf[6] = *(const __attribute__((address_space(3))) bf16x8*)(kp + 6144); kf[7] = *(const __attribute__((address_space(3))) bf16x8*)(kp + 6656);
}
__device__ __forceinline__ void kload2(bf16x8* kf, lds_cptr kp, int j) { kf[2 * j] = *(const __attribute__((address_space(3))) bf16x8*)(kp + j * 2048); kf[2 * j + 1] = *(const __attribute__((address_space(3))) bf16x8*)(kp + j * 2048 + 512); }
__device__ __forceinline__ s16x4 vtr(lds_cptr p) { return __builtin_bit_cast(s16x4, __builtin_amdgcn_ds_read_tr16_b64_v4i16((__attribute__((address_space(3))) v4i16_t*)p)); }
__device__ __forceinline__ float rowmax(const f32x16& p0, const f32x16& p1) {
    float a = max3f(p0[0], p0[1], p1[0]), b = max3f(p0[2], p0[3], p1[1]); a = max3f(a, p1[2], p1[3]);
#pragma unroll
    for (int r = 4; r < 16; r += 4) { a = max3f(a, p0[r], p0[r + 1]); b = max3f(b, p0[r + 2], p0[r + 3]); a = max3f(a, p1[r], p1[r + 1]); b = max3f(b, p1[r + 2], p1[r + 3]); }
    const float m = max2f(a, b);
    auto rr = __builtin_amdgcn_permlane32_swap(__float_as_uint(m), __float_as_uint(m), false, false);
    return max2f(__uint_as_float(rr[0]), __uint_as_float(rr[1]));
}
__device__ __forceinline__ void pv(f32x16* o, int vb, bf16x8 pa0, bf16x8 pa1, bf16x8 pa2, bf16x8 pa3) {
#pragma unroll
    for (int d0 = 0; d0 < 2; ++d0) { s16x4 lo[4], hi[4];
#pragma unroll
        for (int ks = 0; ks < 4; ++ks) {
            asm volatile("ds_read_b64_tr_b16 %0,%1 offset:%c2" : "=&v"(lo[ks]) : "v"(vb), "i"(d0 * 4096 + ks * 1024) : "memory");
            asm volatile("ds_read_b64_tr_b16 %0,%1 offset:%c2" : "=&v"(hi[ks]) : "v"(vb), "i"(d0 * 4096 + ks * 1024 + 512) : "memory"); }
        asm volatile("s_waitcnt lgkmcnt(0)" ::: "memory"); SBAR();
#define PK(k) (bf16x8){lo[k][0], lo[k][1], lo[k][2], lo[k][3], hi[k][0], hi[k][1], hi[k][2], hi[k][3]}
        o[d0] = __builtin_amdgcn_mfma_f32_32x32x16_bf16(pa0, PK(0), o[d0], 0, 0, 0);
        o[d0] = __builtin_amdgcn_mfma_f32_32x32x16_bf16(pa1, PK(1), o[d0], 0, 0, 0);
        o[d0] = __builtin_amdgcn_mfma_f32_32x32x16_bf16(pa2, PK(2), o[d0], 0, 0, 0);
        o[d0] = __builtin_amdgcn_mfma_f32_32x32x16_bf16(pa3, PK(3), o[d0], 0, 0, 0);
#undef PK
    }
}
struct UnitP {
    const bf16* Q; const bf16* K; const bf16* V; bf16* O;
    long rbase; int rstride, rsplit, vmask, vshift;
    int q0, T0, NT;
    int wqmode;
    const float* km; int qb;
    float* lse;
};
template <int KIND, int THRL, int NS = 3>
__device__ __forceinline__ void attn_unit(const UnitP& P, char* shm, const int wv) {
    int t_ = wv * 64 + lane_now();
    const int tid = t_, lane = tid & 63, r32 = lane & 31, hi = lane >> 5; const int wid = __builtin_amdgcn_readfirstlane(tid >> 6);
    const int q0 = P.q0, T0 = P.T0, NT = P.NT;
#define VROW(v) (P.rbase + (long)((v) & P.vmask) * P.rstride + (long)((v) >> P.vshift) * P.rsplit)
    constexpr int OFFV = KIND == 1 ? 6 * SLOTB : LDS_V, OFFWS = KIND == 1 ? 12 * SLOTB : LDS_WS, OFFOST = OFFWS + NW * 64 * 4;
    static_assert(12 * SLOTB + NW * 64 * 4 + NW * 4096 <= MISC_OFF, "dilated-unit LDS layout");
    const unsigned lds0 = (unsigned)(uintptr_t)shm;
    float* wsf = (float*)(shm + OFFWS) + wid * 64;
    const unsigned kdst = lds0 + LDS_K + wid * 1024, vdst = lds0 + OFFV + wid * 1024;
#define DMA_K(t, slot) glds16(P.K + VROW((T0 + (t)) * KVBLK + lane) * PITCH + wid * 8, (unsigned)__builtin_amdgcn_readfirstlane(kdst + (slot)))
#define DMA_V(t, slot) glds16(P.V + VROW((T0 + (t)) * KVBLK + 16 * (wid & 3) + (lane >> 2)) * PITCH + (wid >> 2) * 32 + (lane & 3) * 8, (unsigned)__builtin_amdgcn_readfirstlane(vdst + (slot)))
    const int vb0 = (int)(lds0 + OFFV) + ((lane >> 4) & 1) * 32 + (lane & 3) * 8 + (4 * hi + ((lane & 15) >> 2)) * 64;
    const char* Kbase = shm + LDS_K; bf16x8 kf[8];
    const lds_cptr shm3 = (lds_cptr)shm; const lds_cptr kp0 = shm3 + LDS_K + hi * 1024 + r32 * 16; const lds_cptr vp0 = shm3 + OFFV + ((lane >> 4) & 1) * 32 + (lane & 3) * 8 + (4 * hi + ((lane & 15) >> 2)) * 64;
    const int qrel = wid * QBLK + r32, qv = q0 + qrel;
    bf16x8 qr[4];
    { const bf16* Qw = P.Q + VROW(qv) * PITCH;
#pragma unroll
      for (int d0 = 0; d0 < 4; ++d0) qr[d0] = *reinterpret_cast<const bf16x8*>(&Qw[d0 * 16 + hi * 8]); }
    unsigned wq = 128u; if (KIND == 1 && P.wqmode) wq = (unsigned)(qv & 127);
    if (KIND == 1) {
#pragma unroll
        for (int t = 0; t < 6; ++t) if (t < NT) { DMA_K(t, t * SLOTB); DMA_V(t, t * SLOTB); }
    } else { DMA_K(0, 0); DMA_V(0, 0); DMA_K(1, SLOTB); }
    unsigned sel = 0xffffffffu;
    if (KIND == 0) {
        const int qb = P.qb;
        if (qb > 0) {
            float* tbl = (float*)(shm + OFFOST);
            if (tid < 128) *(f32x4*)(tbl + tid * 4) = *(const f32x4*)(P.km + (size_t)(tid >> 4) * WA + (tid & 15) * 4);
            asm volatile("s_waitcnt vmcnt(0) lgkmcnt(0)\n\ts_barrier" ::: "memory");
            float qf[32];
#pragma unroll
            for (int d0 = 0; d0 < 4; ++d0)
#pragma unroll
                for (int i = 0; i < 8; ++i) qf[d0 * 8 + i] = __uint_as_float(((unsigned)(unsigned short)qr[d0][i]) << 16);
            float g[7];
#pragma unroll
            for (int j = 0; j < 7; ++j) { float s = 0.f;
                if (j < qb) {
#pragma unroll
                    for (int d0 = 0; d0 < 4; ++d0) { const f32x4 k0 = *(const f32x4*)(tbl + j * 64 + d0 * 16 + hi * 8), k1 = *(const f32x4*)(tbl + j * 64 + d0 * 16 + hi * 8 + 4);
                        s += qf[d0 * 8 + 0] * k0[0] + qf[d0 * 8 + 1] * k0[1] + qf[d0 * 8 + 2] * k0[2] + qf[d0 * 8 + 3] * k0[3] + qf[d0 * 8 + 4] * k1[0] + qf[d0 * 8 + 5] * k1[1] + qf[d0 * 8 + 6] * k1[2] + qf[d0 * 8 + 7] * k1[3]; }
                    { auto rr = __builtin_amdgcn_permlane32_swap(__float_as_uint(s), __float_as_uint(s), false, false); s = __uint_as_float(rr[0]) + __uint_as_float(rr[1]); } }
                g[j] = s; }
            sel = 0u; const int nsel = qb < MOBA_TOPK ? qb : MOBA_TOPK;
#pragma unroll
            for (int k = 0; k < MOBA_TOPK; ++k) if (k < nsel) { int best = -1; float bv = -INFINITY;
#pragma unroll
                for (int j = 0; j < 7; ++j) if (j < qb && !((sel >> j) & 1u) && (best < 0 || g[j] > bv)) { bv = g[j]; best = j; }
                sel |= 1u << best; }
            sel |= 1u << qb;
            asm volatile("s_waitcnt lgkmcnt(0)\n\ts_barrier" ::: "memory");
        }
    }
    float zz_ = 0.f; asm volatile("" : "+v"(zz_));
    float mhat = 0.f, l_reg = 0.f; f32x16 o[2]; f32x16 negm;
#pragma unroll
    for (int r = 0; r < 16; ++r) { o[0][r] = zz_; o[1][r] = zz_; negm[r] = zz_; }
    asm volatile("" : "+v"(negm));
#define CMASK(P0, P1, t) do { if (KIND == 0) { int jb_ = (t) - (NT - 4); if (jb_ >= 0) cmask(P0, P1, jb_, qrel, hi); } else { dmask(P0, P1, qv - 64 * (T0 + (t)) - 4 * hi, wq); } } while (0)
#define PRE(t) do { if (KIND == 0) { const float nm_ = ((sel >> ((T0 + (t)) >> 2)) & 1u) ? -mhat : -INFINITY; _Pragma("unroll") for (int r = 0; r < 16; ++r) negm[r] = nm_; asm volatile("" : "+v"(negm)); } } while (0)
    bool resc = false;
#define START(P0, P1) do { const float rm = rowmax(P0, P1); resc = false; \
    { const float dl = (rm == -INFINITY) ? 0.f : rm; mhat = fadd_s(mhat, dl); \
      _Pragma("unroll") for (int r = 0; r < 16; ++r) { P0[r] = fsub_s(P0[r], dl); P1[r] = fsub_s(P1[r], dl); } \
      _Pragma("unroll") for (int r = 0; r < 16; ++r) negm[r] = -mhat; asm volatile("" : "+v"(negm)); } \
    _Pragma("unroll") for (int r = 0; r < 16; ++r) P0[r] = __builtin_amdgcn_exp2f(P0[r]); } while (0)
#define RESC() do { if (resc) { asm volatile("s_waitcnt lgkmcnt(0)" ::: "memory"); \
      _Pragma("unroll") for (int d_ = 0; d_ < 2; ++d_) _Pragma("unroll") for (int r = 0; r < 16; ++r) o[d_][r] *= wsf[crow(r, hi)]; } } while (0)
    f32x16 pA0, pA1, pB0, pB1;
    int sl_prev = 0, sl_cur = 0, sl_next = SLOTB;
#define ROT() do { sl_prev = sl_cur; sl_cur = sl_next; sl_next = (sl_next == (NSLOT - 1) * SLOTB) ? 0 : sl_next + SLOTB; } while (0)
#define ROT1() do { sl_prev = sl_cur; sl_cur = sl_next; sl_next = sl_next + SLOTB; } while (0)
    int tl = 0;
    if (KIND == 1) {
        const int ns = NS, qw = q0 + wid * QBLK;
        int first = (P.wqmode ? ((qw & ~127) - 64 * T0) : (qw - 127 - 64 * T0)) >> 6; first = first < 0 ? 0 : first;
        tl = first < NT - ns ? first : NT - ns;
        asm volatile("s_waitcnt vmcnt(0) lgkmcnt(0)\n\ts_barrier" ::: "memory");
        sl_cur = tl * SLOTB;
        qkt(pA0, pA1, Kbase + sl_cur, qr, negm, r32, hi); asm volatile("s_nop 15\n\ts_nop 7" : "+v"(pA0), "+v"(pA1)); CMASK(pA0, pA1, tl);
        START(pA0, pA1);
        _Pragma("unroll") for (int r = 0; r < 16; ++r) pA1[r] = __builtin_amdgcn_exp2f(pA1[r]);
        sl_prev = sl_cur; sl_cur += SLOTB; sl_next = sl_cur + SLOTB;
        kload8(kf, kp0 + sl_cur);
    } else {
    DMA_K(2, 2 * SLOTB);
    WAIT_BAR(3);
    PRE(0);
    qkt(pA0, pA1, Kbase, qr, negm, r32, hi); asm volatile("s_nop 15\n\ts_nop 7" : "+v"(pA0), "+v"(pA1)); CMASK(pA0, pA1, 0);
    START(pA0, pA1);
    _Pragma("unroll") for (int r = 0; r < 16; ++r) pA1[r] = __builtin_amdgcn_exp2f(pA1[r]);
    WAIT_BAR(0);
    DMA_K(3, 0); DMA_V(1, SLOTB);
    ROT();
    kload8(kf, kp0 + sl_cur);
    WAIT_BAR(2);
    }
    s16x4 vlo[8], vhi[8]; u32x4 pw0, pw1, pw2, pw3;
#define PKW(P, B) cvtpk_s(P[B], P[B + 1])
#define PAF(k) __builtin_bit_cast(bf16x8, pw##k)
#define VFR(i) (bf16x8){vlo[i][0], vlo[i][1], vlo[i][2], vlo[i][3], vhi[i][0], vhi[i][1], vhi[i][2], vhi[i][3]}
#define PIN(x) asm volatile("" : "+v"(x))
#define MX3(a, b, c) __builtin_fmaxf(__builtin_fmaxf((a), (b)), (c))
#define GAPA(MF, A0, A1, A2, A3, W0, W1, PW) do { MF; sacc += A0; sacc += A1; sacc += A2; sacc += A3; PIN(sacc); W0; W1; PIN(PW); SBAR(); } while (0)
#define EX(v) __builtin_amdgcn_exp2f(v)
#define GAPB(MF, X, B) do { MF; X[B] = EX(X[B]); X[B + 1] = EX(X[B + 1]); X[B + 2] = EX(X[B + 2]); X[B + 3] = EX(X[B + 3]); PIN(X); SBAR(); } while (0)
#define VRD(i) do { vlo[i] = vtr(vp_ + (((i) >> 2) * 4096 + ((i) & 3) * 1024)); vhi[i] = vtr(vp_ + (((i) >> 2) * 4096 + ((i) & 3) * 1024 + 512)); } while (0)
#define KRD(G, j) do { if (G) { kload2(kf, kp0 + sl_next, j); SBAR(); } } while (0)
#define STEP(C0, C1, P0, P1, t, GK, GV, GL) do { PRE(t); SBAR(); \
    const lds_cptr vp_ = vp0 + sl_prev; \
    VRD(0); SBAR(); float sacc = (P0[0] + P0[1]); \
    GAPA(C0 = __builtin_amdgcn_mfma_f32_32x32x16_bf16(kf[0], qr[0], negm, 0, 0, 0), P0[2], P0[3], P0[4], P0[5],     pw0[0] = PKW(P0, 0), pw0[1] = PKW(P0, 2), pw0); \
    VRD(4); SBAR(); GAPA(C1 = __builtin_amdgcn_mfma_f32_32x32x16_bf16(kf[1], qr[0], negm, 0, 0, 0), P0[6], P0[7], P0[8], P0[9],     pw0[2] = PKW(P0, 4), pw0[3] = PKW(P0, 6), pw0); \
    VRD(1); SBAR(); GAPA(C0 = __builtin_amdgcn_mfma_f32_32x32x16_bf16(kf[2], qr[1], C0, 0, 0, 0),   P0[10], P0[11], P0[12], P0[13], pw1[0] = PKW(P0, 8), pw1[1] = PKW(P0, 10), pw1); \
    VRD(5); SBAR(); GAPA(C1 = __builtin_amdgcn_mfma_f32_32x32x16_bf16(kf[3], qr[1], C1, 0, 0, 0),   P0[14], P0[15], P1[0], P1[1],   pw1[2] = PKW(P0, 12), pw1[3] = PKW(P0, 14), pw1); \
    VRD(2); SBAR(); GAPA(C0 = __builtin_amdgcn_mfma_f32_32x32x16_bf16(kf[4], qr[2], C0, 0, 0, 0),   P1[2], P1[3], P1[4], P1[5],     pw2[0] = PKW(P1, 0), pw2[1] = PKW(P1, 2), pw2); \
    VRD(6); SBAR(); GAPA(C1 = __builtin_amdgcn_mfma_f32_32x32x16_bf16(kf[5], qr[2], C1, 0, 0, 0),   P1[6], P1[7], P1[8], P1[9],     pw2[2] = PKW(P1, 4), pw2[3] = PKW(P1, 6), pw2); \
    VRD(3); SBAR(); GAPA(C0 = __builtin_amdgcn_mfma_f32_32x32x16_bf16(kf[6], qr[3], C0, 0, 0, 0),   P1[10], P1[11], P1[12], P1[13], pw3[0] = PKW(P1, 8), pw3[1] = PKW(P1, 10), pw3); \
    VRD(7); SBAR(); GAPA(C1 = __builtin_amdgcn_mfma_f32_32x32x16_bf16(kf[7], qr[3], C1, 0, 0, 0),   P1[14], P1[15], 0.f, 0.f,       pw3[2] = PKW(P1, 12), pw3[3] = PKW(P1, 14), pw3); \
    l_reg += sacc; \
    if (GK) { DMA_K((t) + 3, sl_cur); } if (GV) { DMA_V((t) + 1, sl_next); } \
    CMASK(C0, C1, t); \
    { float a = MX3(C0[0], C0[1], C1[0]), b = MX3(C0[2], C0[3], C1[1]); a = MX3(a, C1[2], C1[3]); \
      _Pragma("unroll") for (int r = 4; r < 16; r += 4) { a = MX3(a, C0[r], C0[r + 1]); b = MX3(b, C0[r + 2], C0[r + 3]); a = MX3(a, C1[r], C1[r + 1]); b = MX3(b, C1[r + 2], C1[r + 3]); } \
      float rm = __builtin_fmaxf(a, b); { auto rr = __builtin_amdgcn_permlane32_swap(__float_as_uint(rm), __float_as_uint(rm), false, false); rm = __builtin_fmaxf(__uint_as_float(rr[0]), __uint_as_float(rr[1])); } \
      resc = false; \
      if (__builtin_expect(__any(rm > (float)THRL), 0)) { const float dl = __builtin_fmaxf(rm, 0.f); mhat += dl; \
        _Pragma("unroll") for (int r = 0; r < 16; ++r) { C0[r] -= dl; C1[r] -= dl; } \
        _Pragma("unroll") for (int r = 0; r < 16; ++r) negm[r] = -mhat; asm volatile("" : "+v"(negm)); \
        const float f = __builtin_amdgcn_exp2f(-dl); l_reg *= f; if (hi == 0) wsf[r32] = f; resc = true; } } \
    SBAR(); \
    GAPB(o[0] = __builtin_amdgcn_mfma_f32_32x32x16_bf16(PAF(0), VFR(0), o[0], 0, 0, 0), C0, 0); \
    GAPB(o[1] = __builtin_amdgcn_mfma_f32_32x32x16_bf16(PAF(0), VFR(4), o[1], 0, 0, 0), C0, 4); \
    KRD(GL, 0); GAPB(o[0] = __builtin_amdgcn_mfma_f32_32x32x16_bf16(PAF(1), VFR(1), o[0], 0, 0, 0), C0, 8); \
    KRD(GL, 1); GAPB(o[1] = __builtin_amdgcn_mfma_f32_32x32x16_bf16(PAF(1), VFR(5), o[1], 0, 0, 0), C0, 12); \
    KRD(GL, 2); GAPB(o[0] = __builtin_amdgcn_mfma_f32_32x32x16_bf16(PAF(2), VFR(2), o[0], 0, 0, 0), C1, 0); \
    KRD(GL, 3); GAPB(o[1] = __builtin_amdgcn_mfma_f32_32x32x16_bf16(PAF(2), VFR(6), o[1], 0, 0, 0), C1, 4); \
    GAPB(o[0] = __builtin_amdgcn_mfma_f32_32x32x16_bf16(PAF(3), VFR(3), o[0], 0, 0, 0), C1, 8); \
    GAPB(o[1] = __builtin_amdgcn_mfma_f32_32x32x16_bf16(PAF(3), VFR(7), o[1], 0, 0, 0), C1, 12); \
    } while (0)
    int t = 1;
#define ENDW(tt) do { if ((tt) + 3 < NT) { WAIT_BAR(2); } else if ((tt) + 2 < NT) { WAIT_BAR(1); } else { WAIT_BAR(0); } } while (0)
    if (KIND == 0) {
#undef CMASK
#define CMASK(P0, P1, t) do { } while (0)
        for (; t + 5 < NT; t += 2) {
            STEP(pB0, pB1, pA0, pA1, t, true, true, true);     WAIT_BAR(2); RESC(); ROT();
            STEP(pA0, pA1, pB0, pB1, t + 1, true, true, true); WAIT_BAR(2); RESC(); ROT();
        }
#undef CMASK
#define CMASK(P0, P1, t) do { if (KIND == 0) { int jb_ = (t) - (NT - 4); if (jb_ >= 0) cmask(P0, P1, jb_, qrel, hi); } else { dmask(P0, P1, qv - 64 * (T0 + (t)) - 4 * hi, wq); } } while (0)
    }
#define FINAL(Q0, Q1) do { float sacc = Q0[0] + Q0[1]; _Pragma("unroll") for (int r = 2; r < 16; ++r) sacc += Q0[r]; _Pragma("unroll") for (int r = 0; r < 16; ++r) sacc += Q1[r]; l_reg += sacc; \
      pw0 = (u32x4){PKW(Q0, 0), PKW(Q0, 2), PKW(Q0, 4), PKW(Q0, 6)}; pw1 = (u32x4){PKW(Q0, 8), PKW(Q0, 10), PKW(Q0, 12), PKW(Q0, 14)}; pw2 = (u32x4){PKW(Q1, 0), PKW(Q1, 2), PKW(Q1, 4), PKW(Q1, 6)}; pw3 = (u32x4){PKW(Q1, 8), PKW(Q1, 10), PKW(Q1, 12), PKW(Q1, 14)}; \
      SBAR(); pv(o, vb0 + sl_cur, PAF(0), PAF(1), PAF(2), PAF(3)); } while (0)
    if (KIND == 1) {
        if (NS == 2) { STEP(pB0, pB1, pA0, pA1, tl + 1, false, false, false); RESC(); FINAL(pB0, pB1); }
        else { STEP(pB0, pB1, pA0, pA1, tl + 1, false, false, true); RESC(); ROT1();
               STEP(pA0, pA1, pB0, pB1, tl + 2, false, false, false); RESC(); FINAL(pA0, pA1); }
    } else {
    for (; t + 1 < NT; t += 2) {
        STEP(pB0, pB1, pA0, pA1, t, (t + 3 < NT), (t + 1 < NT), (t + 1 < NT));         ENDW(t);     RESC(); ROT();
        STEP(pA0, pA1, pB0, pB1, t + 1, (t + 4 < NT), (t + 2 < NT), (t + 2 < NT));     ENDW(t + 1); RESC(); ROT();
    }
    STEP(pB0, pB1, pA0, pA1, NT - 1, false, false, false); RESC();
    FINAL(pB0, pB1);
    }
#undef FINAL
#undef PKW
#undef PAF
#undef VFR
#undef PIN
#undef MX3
#undef GAPA
#undef GAPB
#undef EX
#undef VRD
#undef KRD
#undef STEP
#undef ENDW
    { auto rr = __builtin_amdgcn_permlane32_swap(__float_as_uint(l_reg), __float_as_uint(l_reg), false, false); l_reg = __uint_as_float(rr[0]) + __uint_as_float(rr[1]); }
    if (hi == 0) wsf[32 + r32] = l_reg; asm volatile("s_waitcnt lgkmcnt(0)" ::: "memory");
    if (KIND == 1) { if (hi == 0) P.lse[(size_t)VROW(qv) * 4] = mhat + __builtin_amdgcn_logf(l_reg); }
    float rli[16];
#pragma unroll
    for (int r = 0; r < 16; ++r) rli[r] = __builtin_amdgcn_rcpf(wsf[32 + crow(r, hi)]);
    { bf16* stg = (bf16*)(shm + OFFOST) + wid * 2048;
#pragma unroll
      for (int r = 0; r < 16; ++r) { const int orow = crow(r, hi);
#pragma unroll
          for (int d0 = 0; d0 < 2; ++d0) stg[orow * 64 + d0 * 32 + r32] = (bf16)f2bf(o[d0][r] * rli[r]); }
      asm volatile("s_waitcnt lgkmcnt(0)" ::: "memory");
#pragma unroll
      for (int i = 0; i < 4; ++i) { const int row = i * 8 + (lane >> 3), ch = lane & 7; const u32x4 v = *(const u32x4*)(stg + row * 64 + ch * 8);
          *(u32x4*)(P.O + VROW(q0 + wid * QBLK + row) * PITCH + ch * 8) = v; } }
    asm volatile("s_waitcnt lgkmcnt(0)\n\ts_barrier" ::: "memory");
#undef DMA_K
#undef DMA_V
#undef CMASK
#undef PRE
#undef START
#undef RESC
#undef ROT
#undef ROT1
#undef VROW
}
#undef SBAR
#undef WAIT_BAR
}

template <bool DO_MOBA, bool DO_DIL>
__device__ __forceinline__ void attn_phase(char* shm, bf16* QKV, const float* KML, float* LSE, const int wv) {
    const int G = gridDim.x, bx = blockIdx.x; const int vcu = (G % 8 == 0) ? (bx % 8) * (G / 8) + bx / 8 : bx;
    if (DO_DIL) for (int u = vcu; u < 1536; u += G) {
        attn_body::UnitP P; const int g = u >> 9, w = u & 511; int b, h, qb = 0, r = 0;
        if (g == 0) { qb = w & 7; b = w >> 5; h = (w >> 3) & 3; }
        else if (g == 1) { qb = w & 1; const int rest = w >> 1; b = rest >> 4; r = (rest >> 2) & 3; h = rest & 3; }
        else { b = w >> 5; r = 2 * ((w >> 2) & 7); h = w & 3; }
        const int head = 4 * g + h;
        P.Q = QKV_AT(QKV, C_QB + head * 64, 0); P.K = QKV_AT(QKV, C_KB + head * 64, 0); P.V = QKV_AT(QKV, C_VB + head * 64, 0); P.O = QKV_AT(QKV, C_QB + head * 64, 0);
        P.rbase = (long)b * SEQ + r; P.rstride = g == 0 ? 1 : (g == 1 ? 4 : 16); P.rsplit = g == 2 ? 1 : 0; P.vmask = g == 2 ? 127 : 0x7fffffff; P.vshift = g == 2 ? 7 : 31;
        P.q0 = qb * 256; P.T0 = qb == 0 ? 0 : 4 * qb - 2; P.NT = qb == 0 ? 4 : 6; P.wqmode = g == 2 ? 1 : 0; P.km = nullptr; P.qb = 0; P.lse = LSE + (size_t)g * M * 4 + h;
        if (g == 2) attn_body::attn_unit<1, 8, 2>(P, shm, wv); else attn_body::attn_unit<1, 8, 3>(P, shm, wv);
    }
    if (DO_MOBA) for (int it = vcu; it < 512; it += G) { const int bh = it >> 2, e = it & 3, b = bh >> 3, h = bh & 7;
        for (int k = 0; k < 2; ++k) { const int qb = k ? 7 - e : e;
            attn_body::UnitP P; P.Q = QKV_AT(QKV, C_QA + h * 64, 0); P.K = QKV_AT(QKV, C_KA + h * 64, 0); P.V = QKV_AT(QKV, C_VA + h * 64, 0); P.O = QKV_AT(QKV, C_QA + h * 64, 0);
            P.rbase = (long)b * SEQ; P.rstride = 1; P.rsplit = 0; P.vmask = 0x7fffffff; P.vshift = 31;
            P.q0 = qb * 256; P.T0 = 0; P.NT = 4 * qb + 4; P.wqmode = 0; P.km = KML + (size_t)(b * NBLK) * WA + h * 64; P.qb = qb; P.lse = nullptr;
            attn_body::attn_unit<0, 8>(P, shm, wv); } }
}
__device__ __forceinline__ void dil_combine_phase(bf16* QKV, const float* LSE, const int wv) {
    int t_ = wv * 64 + lane_now(); const int lane = t_ & 63, wave = __builtin_amdgcn_readfirstlane(t_ >> 6);
    const int gw = blockIdx.x * NWAVES + wave, NGW = gridDim.x * NWAVES, slot = lane >> 4;
    for (int m0 = gw * 8; m0 < M; m0 += NGW * 8) {
        float l[8][3]; u32x2 ov[8][3];
#pragma unroll
        for (int q = 0; q < 8; ++q) { const int m = m0 + q; const bf16* p = QKV_AT(QKV, C_QB + slot * 64, m) + (lane & 15) * 4;
#pragma unroll
            for (int g = 0; g < 3; ++g) { l[q][g] = LSE[((size_t)g * M + m) * 4 + slot]; ov[q][g] = *(const u32x2*)(p + (size_t)4 * g * HSLOT); } }
#pragma unroll
        for (int q = 0; q < 8; ++q) { const int m = m0 + q; bf16* p = QKV_AT(QKV, C_QB + slot * 64, m) + (lane & 15) * 4;
            const float mx = fmaxf(l[q][0], fmaxf(l[q][1], l[q][2])); float w0 = __builtin_amdgcn_exp2f(l[q][0] - mx), w1 = __builtin_amdgcn_exp2f(l[q][1] - mx), w2 = __builtin_amdgcn_exp2f(l[q][2] - mx);
            const float inv = 1.f / (w0 + w1 + w2); w0 *= inv; w1 *= inv; w2 *= inv;
            f32x4 o;
#pragma unroll
            for (int i = 0; i < 4; ++i) { const unsigned a = i < 2 ? ov[q][0].x : ov[q][0].y, b = i < 2 ? ov[q][1].x : ov[q][1].y, c = i < 2 ? ov[q][2].x : ov[q][2].y;
                const float fa = (i & 1) ? bf2f(a >> 16) : bf2f(a & 0xffffu), fb = (i & 1) ? bf2f(b >> 16) : bf2f(b & 0xffffu), fc = (i & 1) ? bf2f(c >> 16) : bf2f(c & 0xffffu);
                o[i] = fa * w0 + fb * w1 + fc * w2; }
            st_bf16x4(p, o); }
    }
}
constexpr int N_PHASES = 27;
struct Args { const float* in[21]; float* out; unsigned char* ws; int ph_lo, ph_hi; };
__global__ void __launch_bounds__(NTHREADS, 2) fwd(Args args) {
    extern __shared__ __attribute__((aligned(16))) unsigned char lds_raw[];
    LAS unsigned char* lds = (LAS unsigned char*)lds_raw;
    volatile LAS unsigned* MISC = (volatile LAS unsigned*)(lds + MISC_OFF);
    const int tid = threadIdx.x, lane = tid & 63, wave = __builtin_amdgcn_readfirstlane(tid >> 6);
    unsigned char* ws = args.ws;
    gu32* ctl = (gu32*)(ws + WS_CTL);
    for (int u = tid; u < (LDS_BYTES - RING_BYTES) / 4; u += NTHREADS) ((LAS unsigned*)(lds + RING_BYTES))[u] = 0u;
    __syncthreads();
    XcdBarrier bar; bar.bar = (unsigned*)(ctl + CW_BAR); bar.x = 0; bar.st = nullptr;
    if (!MK_MULTI) bar = xcd_barrier_post((unsigned*)(ctl + CW_BAR), MISC + 8);
    bar.w = wave;
    const int lo = args.ph_lo, hi = args.ph_hi;
#define IN(k) (lo <= (k) && (k) < hi)
#define SEAM(k) do { if (!MK_MULTI && IN((k) + 1)) xcd_barrier(bar); } while (0)

    float* KM = (float*)(ws + WS_KMEAN);
    bf16* H = (bf16*)(ws + WS_H); bf16* QKV = (bf16*)(ws + WS_QKV); bf16* GATES = (bf16*)(ws + WS_GATES); bf16* ACT = (bf16*)(ws + WS_ACT);
    bf16* WSM = (bf16*)(ws + WS_WSM);
    float* X = args.out; float* LSE = (float*)(ws + WS_LSE);
    const int G = gridDim.x, bid = blockIdx.x;

    if (IN(0)) {
        for (int i = bid * NTHREADS + tid; i < 2 * (M / 256) * WA; i += G * NTHREADS) KM[i] = 0.f;
        LAS float* scr = (LAS float*)(lds + wave * 16384);
        const int gw = bid * NWAVES + wave, NGW = G * NWAVES;
        { const int wb = 1;
            convert_job<1>(args.in[wb + 1], D, NIN, (bf16*)((char*)WSM + WSM_IN), D, 0, scr, gw, NGW, lane);
            convert_job<0>(args.in[wb + 2], WA, D, (bf16*)((char*)WSM + WSM_MRG), 768, 0, scr, (gw + NGW - (2944 % NGW)) % NGW, NGW, lane);
            convert_job<0>(args.in[wb + 3], WBO, D, (bf16*)((char*)WSM + WSM_MRG), 768, WA, scr, (gw + NGW - (3200 % NGW)) % NGW, NGW, lane);
            convert_job<0>(args.in[wb + 4], D, D, (bf16*)((char*)WSM + WSM_OUT), D, 0, scr, (gw + NGW - (3328 % NGW)) % NGW, NGW, lane); }
        if (!IN(1)) SEAM(0); else __syncthreads(); }
    for (int L = 0; L < 2; ++L) {
        const int pb = L == 0 ? 1 : 10, wb = L == 0 ? 1 : 10;
        const float* xin = L == 0 ? args.in[0] : X;
        const float* nm = args.in[wb]; const float* nf = args.in[wb + 5];
        float* KML = KM + (size_t)L * (M / 256) * WA;
        const char* Bin = (const char*)WSM + WSM_IN + (size_t)L * NIN * D * 2; const char* Bmrg = (const char*)WSM + WSM_MRG + (size_t)L * D * 768 * 2; const char* Bout = (const char*)WSM + WSM_OUT + (size_t)L * D * D * 2;
        if (IN(pb + 0) && L == 0) { norm_phase<false>(xin, nm, H, nullptr, nullptr, nullptr, nullptr, wave); SEAM(pb + 0); }
        if (IN(pb + 1)) {
            pg8::SchedPlain S; S.o.init(M / 256, NIN / 256, G, bid); S.A = (const char*)H; S.B = Bin; S.lda = D; S.ldb = D; S.ntk = D / 64; S.rowmajor();
            pg8::EpiInProj E{QKV, GATES, KML};
            if (L == 1 && G == 256 && bid >= 128) {
#pragma unroll 1
                for (int i = 0; i < 3; ++i) __builtin_amdgcn_s_sleep(127); }
            pg8::gemm_phase<pg8::EpiInProj, pg8::SchedPlain, true>(lds, S, E, wave);
            if (L == 0) {
                const bool sub = (G == 256);
                if (!sub || bid >= 128) { __syncthreads();
                    int t2_ = wave * 64 + lane_now(); const int lane = t2_ & 63, wave = __builtin_amdgcn_readfirstlane(t2_ >> 6);
                    LAS float* scr = (LAS float*)(lds + wave * 16384);
                    const int gw = sub ? (bid - 128) * NWAVES + wave : bid * NWAVES + wave, NGW = sub ? 128 * NWAVES : G * NWAVES;
                    convert_job<1>(args.in[11], D, NIN, (bf16*)((char*)WSM + WSM_IN) + (size_t)NIN * D, D, 0, scr, gw, NGW, lane);
                    convert_job<0>(args.in[12], WA, D, (bf16*)((char*)WSM + WSM_MRG) + (size_t)D * 768, 768, 0, scr, (gw + NGW - (2944 % NGW)) % NGW, NGW, lane);
                    convert_job<0>(args.in[13], WBO, D, (bf16*)((char*)WSM + WSM_MRG) + (size_t)D * 768, 768, WA, scr, (gw + NGW - (3200 % NGW)) % NGW, NGW, lane);
                    convert_job<0>(args.in[14], D, D, (bf16*)((char*)WSM + WSM_OUT) + (size_t)D * D, D, 0, scr, (gw + NGW - (3328 % NGW)) % NGW, NGW, lane);
                    convert_job<2>(args.in[7], D, FF0, (bf16*)((char*)WSM + WSM_GU0), D, 0, scr, (gw + NGW - (3840 % NGW)) % NGW, NGW, lane, false, 1.4426950408889634f);
                    convert_job<3>(args.in[8], D, FF0, (bf16*)((char*)WSM + WSM_GU0), D, 0, scr, (gw + NGW - (5248 % NGW)) % NGW, NGW, lane, false, 0.6931471805599453f);
                    convert_job<0>(args.in[9], FF0, D, (bf16*)((char*)WSM + WSM_DN0), FF0, 0, scr, (gw + NGW - (6656 % NGW)) % NGW, NGW, lane, true); } }
            SEAM(pb + 1); }
        if (IN(pb + 2)) {
            attn_phase<true, true>((char*)lds_raw, QKV, KML, LSE, wave);
            SEAM(pb + 2); }
        if (IN(pb + 3)) { dil_combine_phase(QKV, LSE, wave); SEAM(pb + 3); }
        if (IN(pb + 4)) {
            pg8::SchedMerge S; S.o.init(M / 256, D / 256, G, bid); S.A1 = (const char*)QKV_AT(QKV, C_QA, 0); S.A2 = (const char*)QKV_AT(QKV, C_QB, 0); S.B = Bmrg; S.lda = 64; S.ldb = 768;
            pg8::EpiMerge2 E{GATES, H};
            pg8::gemm_phase<pg8::EpiMerge2, pg8::SchedMerge, true, 16>(lds, S, E, wave);
            SEAM(pb + 4); }
        if (IN(pb + 5)) {
            pg8::SchedPlain S; S.o.init(M / 256, D / 256, G, bid); S.A = (const char*)H; S.B = Bout; S.lda = D; S.ldb = D; S.ntk = D / 64; S.rowmajor();
            if (L == 0) { pg8::EpiResNorm E{xin, X, nf, H, (float*)(ws + WS_XCH), ctl + CW_PCNT, lds + RING_BYTES + 2048};
                          pg8::gemm_phase<pg8::EpiResNorm, pg8::SchedPlain, true>(lds, S, E, wave); }
            else { pg8::EpiRes2 E{xin, X};
                   pg8::gemm_phase<pg8::EpiRes2, pg8::SchedPlain, true, 16>(lds, S, E, wave); }
            SEAM(pb + 5); }
        if (L == 0) {
            if (IN(pb + 7)) {
                pg8::SchedPlain S; S.o.init(M / 256, 2 * FF0 / 256, G, bid); S.A = (const char*)H; S.B = (const char*)WSM + WSM_GU0; S.lda = D; S.ldb = D; S.ntk = D / 64; S.rowmajor();
                pg8::EpiSwiglu2 E{ACT, FF0};
                pg8::gemm_phase<pg8::EpiSwiglu2, pg8::SchedPlain, true, 8>(lds, S, E, wave);
                SEAM(pb + 7); }
            if (IN(pb + 8)) {
                pg8::SchedPlain S; S.o.init(M / 256, D / 256, G, bid); S.A = (const char*)ACT; S.B = (const char*)WSM + WSM_DN0; S.ntk = FF0 / 64; S.tiled();
                pg8::EpiResNorm E{X, X, args.in[10], H, (float*)(ws + WS_XCH) + (size_t)M * 4, ctl + CW_PCNT + 128 * 16, lds + RING_BYTES + 2048};
                pg8::gemm_phase<pg8::EpiResNorm, pg8::SchedPlain, true>(lds, S, E, wave);
                SEAM(pb + 8); }
        } else {
            int* tokrow = (int*)(ws + WS_TOK); float* wrow = (float*)(tokrow + 2 * MOE_LROWS); int* tk_e = (int*)(wrow + 2 * MOE_LROWS); float* tk_w = (float*)(tk_e + M); int* tokposA = (int*)(ws + WS_TOK + MiB);
            bf16* Hs = (bf16*)(ws + WS_HS); bf16* ACT1 = (bf16*)(ws + WS_ACT1); const char* EXPW = (const char*)(ws + WS_EXPW);
            if (IN(pb + 6)) { moe_router_phase(lds, X, nf, H, args.in[16], args.in[17], args.in[18], args.in[19], tk_e, tk_w, tokrow, ws, ctl, wave); SEAM(pb + 6); }
            if (IN(pb + 7)) { moe_dispatch_phase(lds, H, Hs, tk_e, tk_w, tokrow, wrow, ctl, tokposA, wave); SEAM(pb + 7); }
            bf16* ACTr = (bf16*)(ws + WS_WSM);
            int tsA[9], tsB[9]; tsA[0] = 0; tsB[0] = 0;
            {
#pragma unroll
                for (int e = 0; e < NEXP; ++e) { tsA[e + 1] = tsA[e] + (int)((__hip_atomic_load(ctl + CW_CNT + e, RLX_AGENT) + 255u) >> 8); tsB[e + 1] = tsB[e] + (int)((__hip_atomic_load(ctl + CW_CNT + 8 + e, RLX_AGENT) + 255u) >> 8); }
#pragma unroll
                for (int e = 1; e <= NEXP; ++e) { tsA[e] = __builtin_amdgcn_readfirstlane(tsA[e]); tsB[e] = __builtin_amdgcn_readfirstlane(tsB[e]); } }
            for (int j = 0; j < 12; ++j) {
                const int code = j == 0 ? (0 | 0 << 1 | 2 << 2 | 0 << 5) : j == 1 ? (0 | 1 << 1 | 2 << 2 | 0 << 5) : j == 2 ? (0 | 0 << 1 | 0 << 2 | 0 << 5) : j == 3 ? (1 | 0 << 1 | 0 << 2 | 1 << 5)
                               : j == 4 ? (1 | 0 << 1 | 2 << 2 | 2 << 5) : j == 5 ? (0 | 0 << 1 | 1 << 2 | 1 << 4 | 2 << 5) : j == 6 ? (1 | 0 << 1 | 1 << 2 | 3 << 5) : j == 7 ? (1 | 1 << 1 | 2 << 2 | 4 << 5)
                               : j == 8 ? (0 | 1 << 1 | 0 << 2 | 1 << 4 | 4 << 5) : j == 9 ? (1 | 1 << 1 | 0 << 2 | 5 << 5) : j == 10 ? (0 | 1 << 1 | 1 << 2 | 6 << 5) : (1 | 1 << 1 | 1 << 2 | 7 << 5);
                const int type = code & 1, l = (code >> 1) & 1, c = (code >> 2) & 3, skew = (code >> 4) & 1, ph = code >> 5;
                const bool last_of_phase = (j == 2 || j == 3 || j == 5 || j == 6 || j == 8 || j == 9 || j == 10 || j == 11);
                if (!IN(pb + 8 + ph)) continue;
                int ts[9]; ts[0] = 0;
#pragma unroll
                for (int e = 1; e <= NEXP; ++e) ts[e] = l ? tsB[e] : tsA[e];
                const int rt0 = MOE_CH_TILES * c, cap = c < 2 ? MOE_CH_TILES : 8, nrt = ts[8] - rt0 < 0 ? 0 : (ts[8] - rt0 > cap ? cap : ts[8] - rt0);
                const int nrem = ts[8] - 2 * MOE_CH_TILES < 0 ? 0 : ts[8] - 2 * MOE_CH_TILES;
                bf16* ACTb = c < 2 ? ACT1 : ACTr + (size_t)l * 8 * 256 * FFE;
                pg8::SchedMoe S; S.rt0 = rt0; S.ts1 = ts[1]; S.ts2 = ts[2]; S.ts3 = ts[3]; S.ts4 = ts[4]; S.ts5 = ts[5]; S.ts6 = ts[6]; S.ts7 = ts[7];
                if (type == 0) {
                    int cdeal = bid;
                    if (j == 1) { const int tA = tsA[8];
                        const int nremA = tA - 2 * MOE_CH_TILES < 0 ? 0 : (tA - 2 * MOE_CH_TILES > 8 ? 8 : tA - 2 * MOE_CH_TILES);
                        const int off = ((2 * FFE / 256) * nremA + 7) & ~7; cdeal = (bid + G - (off % G)) % G; }
                    S.o.init(nrt, 2 * FFE / 256, G, cdeal); if (skew) { S.o.nskip = 4 * nrem; S.o.iskip = 6; }
                    S.A = (const char*)(Hs + (size_t)l * MOE_LROWS * D); S.B = EXPW; S.lda = D; S.ldb = D; S.ntk = D / 64; S.rowmajor(); S.estride = (size_t)2 * FFE * D * 2; S.a_chunk_local = false;
                    pg8::EpiSwiglu2 E{ACTb, FFE};
                    pg8::gemm_phase<pg8::EpiSwiglu2, pg8::SchedMoe, true, 8>(lds, S, E, wave);
                } else {
                    S.o.init(nrt, D / 256, G, bid); S.A = (const char*)ACTb; S.B = EXPW + EXPW_DN; S.ntk = FFE / 64; S.tiled(); S.estride = (size_t)D * FFE * 2; S.a_chunk_local = true;
                    if (l == 0) { pg8::EpiMoeDownA E{Hs, wrow};
                                  pg8::gemm_phase<pg8::EpiMoeDownA, pg8::SchedMoe, true>(lds, S, E, wave); }
                    else { pg8::EpiMoeDownNorm E{X, tokrow + (size_t)MOE_LROWS, wrow + (size_t)MOE_LROWS, args.in[20], (float*)(ws + WS_XCH), ctl + CW_PCNT + 2 * 128 * 16, lds + RING_BYTES + 2048, Hs, tokposA};
                           pg8::gemm_phase<pg8::EpiMoeDownNorm, pg8::SchedMoe, true>(lds, S, E, wave); }
                }
                if (last_of_phase && j != 11) SEAM(pb + 8 + ph); else __syncthreads();
            }
        }
    }

#undef IN
#undef SEAM
}

extern "C" void kernel_launch(void* const* d_in, const int* in_sizes, int n_in, void* d_out, int out_size, void* d_ws, size_t ws_size, hipStream_t stream) {
    static int grid = 0;
    if (grid == 0) {
        if (n_in != 21 || out_size != M * D || ws_size < WS_END) { fprintf(stderr, "kernel_launch: unexpected problem (n_in %d out %d ws %zu, need %zu)\n", n_in, out_size, ws_size, (size_t)WS_END); grid = -1; return; }
        int dev = 0, cus = 0, per_cu = 0;
        if (hipGetDevice(&dev) != hipSuccess || hipDeviceGetAttribute(&cus, hipDeviceAttributeMultiprocessorCount, dev) != hipSuccess) { grid = -1; return; }
        if (hipFuncSetAttribute((const void*)fwd, hipFuncAttributeMaxDynamicSharedMemorySize, LDS_BYTES) != hipSuccess) { fprintf(stderr, "kernel_launch: hipFuncSetAttribute failed\n"); grid = -1; return; }
        if (hipOccupancyMaxActiveBlocksPerMultiprocessor(&per_cu, (const void*)fwd, NTHREADS, LDS_BYTES) != hipSuccess || per_cu < 1) fprintf(stderr, "kernel_launch: occupancy query says %d\n", per_cu);
        (void)hipGetLastError();
        grid = cus;
    }
    if (grid < 0) return;
    (void)hipMemsetAsync((char*)d_ws + WS_CTL, 0, CTL_ZERO_BYTES, stream);
    Args a{};
    for (int i = 0; i < 21; ++i) a.in[i] = (const float*)d_in[i];
    a.out = (float*)d_out; a.ws = (unsigned char*)d_ws;
#if MK_MULTI
    for (int p = 0; p < N_PHASES; ++p) { a.ph_lo = p; a.ph_hi = p + 1; hipLaunchKernelGGL(fwd, dim3(grid), dim3(NTHREADS), LDS_BYTES, stream, a); }
#else
    a.ph_lo = 0; a.ph_hi = N_PHASES; hipLaunchKernelGGL(fwd, dim3(grid), dim3(NTHREADS), LDS_BYTES, stream, a);
#endif
}
```
